# Optimizing an MI355X kernel written in HIP

```python
import jax, jax.numpy as jnp
from jax import lax
import numpy as np

D_MODEL = 1024
BATCH = 8
SEQ = 2048
DEPTH = 4

CTX_LEN = 256
GRID_W = 64
HEAD_DIM = 64
D_MIX = D_MODEL
D_CONV = D_MIX // 4
D_RET = D_MIX // 4
D_FNET = D_MIX // 4
D_NAT = D_MIX // 4
N_RET_HEADS = D_RET // HEAD_DIM
N_NAT_HEADS = D_NAT // HEAD_DIM
N_FNET_GROUPS = 4
FNET_GROUP = D_FNET // N_FNET_GROUPS
CHUNK = 128
WIN_H = 8
WIN_W = 16
D_FF = 2816
ROPE_BASE = 10000.0
EPS = 1e-6
NEG = -1e30
D_IN = 3 * D_CONV + 4 * D_RET + D_FNET + 3 * D_NAT
GROUP_OFFSETS = tuple(int(v) for v in np.cumsum([0, 3 * D_CONV, 4 * D_RET, D_FNET, 3 * D_NAT]))

kernel_name = 'hybrid_diffusion_block'

f32 = jnp.float32


def rmsnorm(x, g):
    xf = x.astype(f32)
    y = xf * lax.rsqrt(jnp.mean(xf * xf, -1, keepdims=True) + EPS)
    return (y * g.astype(f32)).astype(x.dtype)


def dwconv3(u, w):
    up = jnp.pad(u, ((0, 0), (1, 1), (0, 0)))
    return up[:, :-2] * w[0] + up[:, 1:-1] * w[1] + up[:, 2:] * w[2]


def axial_rope_tables(n_tok):
    t = jnp.arange(n_tok)
    row = (t // GRID_W).astype(f32)
    col = (t % GRID_W).astype(f32)
    n_freq = HEAD_DIM // 4
    inv = ROPE_BASE ** (-jnp.arange(n_freq, dtype=f32) / n_freq)
    ang = jnp.concatenate([row[:, None] * inv, col[:, None] * inv], -1)
    return jnp.cos(ang), jnp.sin(ang)


def apply_rope(x, cos, sin):
    xf = x.astype(f32)
    x1, x2 = xf[..., :HEAD_DIM // 2], xf[..., HEAD_DIM // 2:]
    cs, sn = cos[None, :, None, :], sin[None, :, None, :]
    return jnp.concatenate([x1 * cs - x2 * sn, x1 * sn + x2 * cs], -1).astype(x.dtype)


def short_conv_mix(p, w):
    u, b, cg = jnp.split(p, 3, -1)
    return b * dwconv3(cg * u, w)


def fourier_mix(p):
    bsz, n, _ = p.shape
    pg = p.astype(f32).reshape(bsz, n, N_FNET_GROUPS, FNET_GROUP)
    f = jnp.fft.fftn(pg, axes=(1, 3), norm='ortho')
    return jnp.real(f).reshape(bsz, n, D_FNET).astype(p.dtype)


def retention_chunkwise(q, k, v, log_gamma, s0):
    bsz, n_tok, nh, hd = q.shape
    n = n_tok // CHUNK
    qc = q.astype(f32).reshape(bsz, n, CHUNK, nh, hd)
    kc = k.astype(f32).reshape(bsz, n, CHUNK, nh, hd)
    vc = v.astype(f32).reshape(bsz, n, CHUNK, nh, hd)
    pos = jnp.arange(CHUNK, dtype=f32)
    diff = pos[:, None] - pos[None, :]
    lg = log_gamma.astype(f32)
    decay = jnp.where(diff >= 0, jnp.exp(lg[:, None, None] * jnp.maximum(diff, 0.0)), 0.0)
    inner = jnp.einsum('bnihd,bnjhd->bnhij', qc, kc) * decay
    y_inner = jnp.einsum('bnhij,bnjhe->bnihe', inner, vc)
    q_decay = jnp.exp(lg[:, None] * (pos + 1.0))
    k_decay = jnp.exp(lg[:, None] * (CHUNK - 1.0 - pos))
    chunk_decay = jnp.exp(lg * CHUNK)[None, :, None, None]
    kv = jnp.einsum('bnjhd,hj,bnjhe->bnhde', kc, k_decay, vc)

    def step(s, kv_n):
        return chunk_decay * s + kv_n, s

    s_final, s_prev = lax.scan(step, s0.astype(f32), jnp.moveaxis(kv, 1, 0))
    s_prev = jnp.moveaxis(s_prev, 0, 1)
    y_cross = jnp.einsum('bnihd,hi,bnhde->bnihe', qc, q_decay, s_prev)
    return (y_inner + y_cross).reshape(bsz, n_tok, nh, hd), s_final


def gated_groupnorm(y, g, dtype):
    mu = jnp.mean(y, -1, keepdims=True)
    var = jnp.mean(jnp.square(y - mu), -1, keepdims=True)
    yn = (y - mu) * lax.rsqrt(var + EPS)
    bsz, n = y.shape[0], y.shape[1]
    return (jax.nn.silu(g.astype(f32)) * yn.reshape(bsz, n, -1)).astype(dtype)


def retention_mix(px, pc, decay_param, cos, sin):
    log_gamma = -jnp.exp(decay_param.astype(f32))

    def heads(t):
        return t.reshape(t.shape[0], t.shape[1], N_RET_HEADS, HEAD_DIM)

    qx, kx, vx, gx = jnp.split(px, 4, -1)
    qc, kc, vc, gc = jnp.split(pc, 4, -1)
    qx, kx, vx = heads(qx), heads(kx), heads(vx)
    qc, kc, vc = heads(qc), heads(kc), heads(vc)
    qx = apply_rope(qx, cos, sin)
    kx = apply_rope(kx, cos, sin) * HEAD_DIM ** -0.5
    kc = kc * HEAD_DIM ** -0.5
    s0 = jnp.zeros((px.shape[0], N_RET_HEADS, HEAD_DIM, HEAD_DIM), f32)
    fl = lambda t: jnp.flip(t, 1)
    yc_f, s_f = retention_chunkwise(qc, kc, vc, log_gamma[0], s0)
    yc_b, s_b = retention_chunkwise(fl(qc), fl(kc), fl(vc), log_gamma[1], s0)
    yx_f, _ = retention_chunkwise(qx, kx, vx, log_gamma[0], s_f)
    yx_b, _ = retention_chunkwise(fl(qx), fl(kx), fl(vx), log_gamma[1], s_b)
    out_x = gated_groupnorm(yx_f + fl(yx_b), gx, px.dtype)
    out_c = gated_groupnorm(yc_f + fl(yc_b), gc, pc.dtype)
    return out_x, out_c


def nat_mix(px, pc, rpb, rows, with_ctx):
    bsz, n_tok, _ = px.shape
    nh, hd = N_NAT_HEADS, HEAD_DIM
    qx, kx, vx = [t.reshape(bsz, n_tok, nh, hd) for t in jnp.split(px, 3, -1)]
    qc, kc, vc = [t.reshape(bsz, pc.shape[1], nh, hd) for t in jnp.split(pc, 3, -1)]
    scale = hd ** -0.5
    kh = min(WIN_H, rows)
    n_cb = GRID_W // WIN_W
    span = 2 * WIN_W
    r = jnp.arange(rows)
    row_idx = jnp.clip(r - kh // 2, 0, rows - kh)[:, None] + jnp.arange(kh)
    cb = jnp.arange(n_cb)
    col_idx = jnp.clip(cb * WIN_W - WIN_W // 2, 0, GRID_W - span)[:, None] + jnp.arange(span)
    q_col = cb[:, None] * WIN_W + jnp.arange(WIN_W)
    q_col_start = jnp.clip(q_col - WIN_W // 2, 0, GRID_W - WIN_W)
    kcol = col_idx[:, None, :]
    in_win = (kcol >= q_col_start[..., None]) & (kcol < q_col_start[..., None] + WIN_W)
    drow = row_idx - r[:, None]
    dcol = jnp.clip(kcol - q_col[:, :, None] + WIN_W - 1, 0, 2 * WIN_W - 2)
    bias = rpb.astype(f32)[:, (drow + WIN_H - 1)[:, None, None, :, None], dcol[None, :, :, None, :]]

    gr = row_idx[:, None, :, None]
    gc = col_idx[None, :, None, :]
    kg = kx.reshape(bsz, rows, GRID_W, nh, hd)[:, gr, gc]
    vg = vx.reshape(bsz, rows, GRID_W, nh, hd)[:, gr, gc]
    qg = (qx * scale).reshape(bsz, rows, n_cb, WIN_W, nh, hd)
    s_loc = jnp.einsum('brcqhd,brckshd->bhrcqks', qg, kg).astype(f32) + bias
    s_loc = jnp.where(in_win[:, :, None, :], s_loc, NEG)
    s_ctx = jnp.einsum('brcqhd,bjhd->bhrcqj', qg, kc).astype(f32)
    n_loc = kh * span
    s_all = jnp.concatenate([s_loc.reshape(s_loc.shape[:5] + (n_loc,)), s_ctx], -1)
    p = jax.nn.softmax(s_all, -1).astype(px.dtype)
    p_loc = p[..., :n_loc].reshape(s_loc.shape)
    o = (jnp.einsum('bhrcqks,brckshe->brcqhe', p_loc, vg)
         + jnp.einsum('bhrcqj,bjhe->brcqhe', p[..., n_loc:], vc))
    y_x = o.reshape(bsz, n_tok, nh * hd)
    if not with_ctx:
        return y_x, None
    s_cc = jnp.einsum('bihd,bjhd->bhij', qc * scale, kc).astype(f32)
    p_cc = jax.nn.softmax(s_cc, -1).astype(pc.dtype)
    y_c = jnp.einsum('bhij,bjhe->bihe', p_cc, vc).reshape(bsz, pc.shape[1], nh * hd)
    return y_x, y_c


def hybrid_mix(px, pc, conv_w, ret_decay, nat_rpb, rows, cos, sin, with_ctx):
    o = GROUP_OFFSETS
    sl = lambda p, i: p[..., o[i]:o[i + 1]]
    ya_x = short_conv_mix(sl(px, 0), conv_w)
    yb_x, yb_c = retention_mix(sl(px, 1), sl(pc, 1), ret_decay, cos, sin)
    yc_x = fourier_mix(sl(px, 2))
    yd_x, yd_c = nat_mix(sl(px, 3), sl(pc, 3), nat_rpb, rows, with_ctx)
    y_x = jnp.concatenate([ya_x, yb_x, yc_x, yd_x], -1)
    if not with_ctx:
        return y_x, None
    y_c = jnp.concatenate([short_conv_mix(sl(pc, 0), conv_w), yb_c, fourier_mix(sl(pc, 2)), yd_c], -1)
    return y_x, y_c


def conv_ffn(h, w_up, w_conv, w_down):
    u = dwconv3(h @ w_up, w_conv)
    a, b = jnp.split(u, 2, -1)
    return (jax.nn.silu(a) * b) @ w_down


def setup_inputs(seed: int = 0) -> dict:
    key = jax.random.key(seed)
    ks = jax.random.split(key, 20)
    D = D_MODEL
    nrm = lambda k, shape, s: jax.random.normal(k, shape, f32) * s
    gain = lambda k: 1.0 + nrm(k, (DEPTH, D), 0.02)
    ret_base = jnp.log(-jnp.log1p(-(2.0 ** (-5.0 - jnp.arange(N_RET_HEADS, dtype=f32)))))
    return {
        'x': nrm(ks[0], (BATCH, SEQ, D), 1.0),
        'c': nrm(ks[1], (BATCH, D), 1.0),
        'ctx': nrm(ks[2], (BATCH, CTX_LEN, D), 1.0),
        'c_ctx': nrm(ks[3], (D,), 1.0),
        'w_mod': nrm(ks[4], (DEPTH, D, 6 * D), 0.3 * D ** -0.5),
        'b_mod': nrm(ks[5], (DEPTH, 6 * D), 0.02),
        'g_pre_mix': gain(ks[6]),
        'g_post_mix': gain(ks[7]),
        'g_pre_ffn': gain(ks[8]),
        'g_post_ffn': gain(ks[9]),
        'w_in': nrm(ks[10], (DEPTH, D, D_IN), D ** -0.5),
        'w_out': nrm(ks[11], (DEPTH, D_MIX, D), D_MIX ** -0.5),
        'conv_w': nrm(ks[12], (DEPTH, 3, D_CONV), 3 ** -0.5),
        'ret_decay': ret_base[None, None, :] + nrm(ks[13], (DEPTH, 2, N_RET_HEADS), 0.1),
        'nat_rpb': nrm(ks[14], (DEPTH, N_NAT_HEADS, 2 * WIN_H - 1, 2 * WIN_W - 1), 0.1),
        'w_up': nrm(ks[15], (DEPTH, D, 2 * D_FF), D ** -0.5),
        'ffn_conv_w': nrm(ks[16], (DEPTH, 3, 2 * D_FF), 3 ** -0.5),
        'w_down': nrm(ks[17], (DEPTH, D_FF, D), D_FF ** -0.5),
    }


def reference(x, c, ctx, c_ctx, w_mod, b_mod, g_pre_mix, g_post_mix, g_pre_ffn, g_post_ffn,
              w_in, w_out, conv_w, ret_decay, nat_rpb, w_up, ffn_conv_w, w_down):
    n_lat = x.shape[1]
    rows = n_lat // GRID_W
    cos, sin = axial_rope_tables(n_lat)
    sc_x = jax.nn.silu(c)
    sc_c = jax.nn.silu(c_ctx)
    for l in range(DEPTH):
        with_ctx = l < DEPTH - 1
        mod_x = (sc_x @ w_mod[l] + b_mod[l])[:, None, :]
        mod_c = sc_c @ w_mod[l] + b_mod[l]
        sh1_x, s1_x, g1_x, sh2_x, s2_x, g2_x = jnp.split(mod_x, 6, -1)
        sh1_c, s1_c, g1_c, sh2_c, s2_c, g2_c = jnp.split(mod_c, 6, -1)
        hx = rmsnorm(x, g_pre_mix[l]) * (1 + s1_x) + sh1_x
        hc = rmsnorm(ctx, g_pre_mix[l]) * (1 + s1_c) + sh1_c
        px = hx @ w_in[l]
        pc = hc @ w_in[l]
        yx, yc = hybrid_mix(px, pc, conv_w[l], ret_decay[l], nat_rpb[l], rows, cos, sin, with_ctx)
        x = x + g1_x * rmsnorm(yx @ w_out[l], g_post_mix[l])
        hx = rmsnorm(x, g_pre_ffn[l]) * (1 + s2_x) + sh2_x
        x = x + g2_x * rmsnorm(conv_ffn(hx, w_up[l], ffn_conv_w[l], w_down[l]), g_post_ffn[l])
        if with_ctx:
            ctx = ctx + g1_c * rmsnorm(yc @ w_out[l], g_post_mix[l])
            hc = rmsnorm(ctx, g_pre_ffn[l]) * (1 + s2_c) + sh2_c
            ctx = ctx + g2_c * rmsnorm(conv_ffn(hc, w_up[l], ffn_conv_w[l], w_down[l]), g_post_ffn[l])
    return x
```

```cpp
#include <hip/hip_runtime.h>
#include <hip/hip_cooperative_groups.h>
#include <cstdio>
#include <cstdint>
namespace cg = cooperative_groups;

#define LAS __attribute__((address_space(3)))
#define DI __device__ __forceinline__
typedef unsigned short bf16_t;
typedef short bf16x8 __attribute__((ext_vector_type(8)));
typedef short bf16x4 __attribute__((ext_vector_type(4)));
typedef float f32x4 __attribute__((ext_vector_type(4)));
typedef unsigned u32x4 __attribute__((ext_vector_type(4)));
typedef unsigned u32x2 __attribute__((ext_vector_type(2)));

constexpr int DM = 1024, NBATCH = 8, SEQ = 2048, CTXL = 256, DEPTH = 4, DIN = 2816, DFF = 2816, NUP = 5632;
constexpr int TL = NBATCH * SEQ, TC = NBATCH * CTXL, TT = TL + TC;
constexpr int NTHREADS = 512;
constexpr int LDS_BYTES = 147456;
constexpr float EPSV = 1e-6f;

constexpr size_t al256(size_t x) { return (x + 255) & ~(size_t)255; }
constexpr size_t WS_CTL = 0;
constexpr size_t WS_BAR = 4096;
constexpr size_t WS_MOD = 32768;
constexpr size_t WS_ROPE = al256(WS_MOD + (size_t)4 * 9 * 6144 * 4);
constexpr size_t WS_CMAT = al256(WS_ROPE + (size_t)2 * 2048 * 32 * 4);
constexpr size_t WS_DFT = al256(WS_CMAT + 128 * 64 * 2);
constexpr size_t WS_DFTC = al256(WS_DFT + (size_t)2048 * 4096 * 2);
constexpr size_t WS_CTX = al256(WS_DFTC + (size_t)256 * 512 * 2);
constexpr size_t WS_H = al256(WS_CTX + (size_t)TC * DM * 4);
constexpr size_t WS_WIN = al256(WS_H + (size_t)TT * DM * 2);
constexpr size_t WS_WOUT = al256(WS_WIN + (size_t)DIN * DM * 2);
constexpr size_t WS_WUP = al256(WS_WOUT + (size_t)DM * DM * 2);
constexpr size_t WS_WDN = al256(WS_WUP + (size_t)NUP * DM * 2);
constexpr size_t WS_A = al256(WS_WDN + (size_t)DM * DFF * 2);
constexpr size_t A_P = 0;
constexpr size_t A_Y = al256(A_P + (size_t)TT * DIN * 2);
constexpr size_t A_VTRL = al256(A_Y + (size_t)TT * DM * 2);
constexpr size_t A_VTRC = al256(A_VTRL + (size_t)32 * 64 * 2048 * 2);
constexpr size_t A_VTNL = al256(A_VTRC + (size_t)32 * 64 * 256 * 2);
constexpr size_t A_VTNC = al256(A_VTNL + (size_t)32 * 64 * 2048 * 2);
constexpr size_t A_END = al256(A_VTNC + (size_t)32 * 64 * 256 * 2);
constexpr size_t A_UB = 0;
constexpr size_t A_O2 = al256((size_t)288 * 4 * 5632 * 4);
static_assert(A_O2 + (size_t)(TL + 4 * TC) * DM * 4 <= A_END, "A region");
constexpr size_t WS_B = al256(WS_A + A_END);
constexpr size_t B_ZT = 0;
constexpr size_t B_ZCT = al256(B_ZT + (size_t)8 * 256 * 4096 * 2);
constexpr size_t B_KV = al256(B_ZCT + (size_t)8 * 256 * 512 * 2);
constexpr size_t B_O1 = 0;
constexpr size_t B_G = 0;
constexpr size_t B_END = al256((size_t)TT * DIN * 2);
static_assert(B_KV + (size_t)8 * 4 * 2 * 18 * 4096 * 4 <= B_END, "B region");
static_assert(B_O1 + (size_t)(TL + 4 * TC) * DM * 4 <= B_END, "B region o1");
constexpr size_t WS_XB = WS_B + B_END;
constexpr size_t WS_END = al256(WS_XB + (size_t)TT * DM * 2);

typedef __bf16 bf2_t __attribute__((ext_vector_type(2)));
typedef float f32x2_t __attribute__((ext_vector_type(2)));
DI unsigned pk2(float lo, float hi) { f32x2_t f = {lo, hi}; bf2_t v = __builtin_convertvector(f, bf2_t); return __builtin_bit_cast(unsigned, v); }
DI unsigned pk2v(float lo, float hi) { return pk2(lo, hi); }
typedef _Float16 h2_t __attribute__((ext_vector_type(2)));
DI unsigned pkh2(float lo, float hi) { h2_t v = {(_Float16)lo, (_Float16)hi}; return __builtin_bit_cast(unsigned, v); }
DI float hlo(unsigned w) { return (float)__builtin_bit_cast(h2_t, w)[0]; }
DI float hhi(unsigned w) { return (float)__builtin_bit_cast(h2_t, w)[1]; }
DI float bflo(unsigned w) { return __uint_as_float(w << 16); }
DI float bfhi(unsigned w) { return __uint_as_float(w & 0xffff0000u); }
DI float wave_sum(float v) {
#pragma unroll
    for (int o = 1; o < 64; o <<= 1) v += __shfl_xor(v, o);
    return v;
}
DI float silu_f(float v) { return v * __builtin_amdgcn_rcpf(1.0f + __builtin_amdgcn_exp2f(-1.44269504089f * v)); }
DI f32x4 mfma16(bf16x8 a, bf16x8 b, f32x4 c) { return __builtin_amdgcn_mfma_f32_16x16x32_bf16(a, b, c, 0, 0, 0); }
DI bf16x8 ld8(const bf16_t* p) { return *(const bf16x8*)p; }
DI bf16x8 cat4(bf16x4 a, bf16x4 b) { bf16x8 r; r[0] = a[0]; r[1] = a[1]; r[2] = a[2]; r[3] = a[3]; r[4] = b[0]; r[5] = b[1]; r[6] = b[2]; r[7] = b[3]; return r; }
DI bf16x8 u4_as_bf8(u32x4 v) { return __builtin_bit_cast(bf16x8, v); }
DI float dpp_ror1(float v) { return __int_as_float(__builtin_amdgcn_update_dpp(0, __float_as_int(v), 0x121, 0xF, 0xF, false)); }
DI float dpp_ror15(float v) { return __int_as_float(__builtin_amdgcn_update_dpp(0, __float_as_int(v), 0x12F, 0xF, 0xF, false)); }

namespace pg8 {
constexpr int BM = 256, BK = 64, HALF = 128, HTB = HALF * BK * 2, STAGE_BYTES = 8 * HTB, NXCD = 8, WGM = 8;
__host__ __device__ __forceinline__ int lds_byte(int r, int c) { const int st = (r >> 4) * 2 + (c >> 5), rr = r & 15, cc = c & 31, ob = rr * 64 + cc * 2; return st * 1024 + (ob ^ (((ob >> 9) & 1) << 5)); }
__host__ __device__ __forceinline__ void stage_rc(int b, int& R, int& C) { const int st = b / 1024, sb = b % 1024, swz = sb ^ (((sb >> 9) & 1) << 5); R = (st >> 1) * 16 + swz / 64; C = (st & 1) * 32 + (swz % 64) / 2; }
__host__ __device__ __forceinline__ int perm32(int rho) { const int n = rho >> 4, i = rho & 15; return 8 * (i >> 2) + 4 * n + (i & 3); }

struct Unit { int pm, pn, ta, tb, k0, nt, ks, sw; };
struct Gemm { const bf16_t* A; const bf16_t* Bt; int K; size_t hstepA, hstepB, tstepA, tstepB; };

struct StaticOrder {
    int nM, nN, nwg, G, c, ntk, extra, swapv;
    __device__ __forceinline__ void init(int M, int N, int G_, int c_, int ntk_, int extra_ = 0, int swapv_ = 0) { nM = M / BM; nN = N / BM; nwg = nM * nN; G = G_; c = c_; ntk = ntk_; extra = extra_; swapv = swapv_; }
    __device__ __forceinline__ bool next(int i, Unit& u) const {
        const long L = (long)i * G + c; if (L >= nwg + extra) return false;
        if (L >= nwg) { const int j = (int)L - nwg, s4 = j & 3; u.pm = 64 + (j >> 2); u.pn = s4 == 0 ? 4 : (s4 == 1 ? 5 : (s4 == 2 ? 9 : 10)); u.ta = u.pm; u.tb = u.pn; u.k0 = 0; u.nt = ntk; u.ks = 0; u.sw = swapv && (s4 & 1); return true; }
        int wgid = (int)L; { const int q = nwg / NXCD, r = nwg % NXCD, xcd = wgid % NXCD, off = wgid / NXCD; wgid = (xcd < r ? xcd * (q + 1) : r * (q + 1) + (xcd - r) * q) + off; }
        const int nig = WGM * nN, gid = wgid / nig, fm = gid * WGM, gsz = (nM - fm) < WGM ? (nM - fm) : WGM;
        u.pm = fm + ((wgid % nig) % gsz); u.pn = (wgid % nig) / gsz; u.ta = u.pm; u.tb = u.pn; u.k0 = 0; u.nt = ntk; u.ks = 0; u.sw = swapv && (u.pn == 5 || u.pn == 10); return true;
    }
};
struct SplitOrder {
    StaticOrder so; int G, c, with_ctx, ntk;
    __device__ __forceinline__ void init(int G_, int c_, int with_ctx_, int ntk_) { so.init(16384, 1024, G_, c_, ntk_); G = G_; c = c_; with_ctx = with_ctx_; ntk = ntk_; }
    __device__ __forceinline__ bool next(int i, Unit& u) const {
        const int L = i * G + c;
        int wgid = L < so.nwg ? L : 0; { const int q = so.nwg / NXCD, r = so.nwg % NXCD, xcd = wgid % NXCD, off = wgid / NXCD; wgid = (xcd < r ? xcd * (q + 1) : r * (q + 1) + (xcd - r) * q) + off; }
        const int nig = WGM * so.nN, gid = wgid / nig, fm = gid * WGM, gsz = (so.nM - fm) < WGM ? (so.nM - fm) : WGM;
        const int apm = fm + ((wgid % nig) % gsz), apn = (wgid % nig) / gsz;
        const int j = L - so.nwg, ks = j & 3;
        const int bpm = 64 + ((j >> 4) & 7), bpn = (j >> 2) & 3;
        const int bk0 = (ntk == 16) ? 4 * ks : (ks < 2 ? 12 * ks : 24 + 10 * (ks - 2)), bnt = (ntk == 16) ? 4 : (ks < 2 ? 12 : 10);
        const bool va = L < so.nwg, vb = (with_ctx != 0) && j >= 0 && j < 128;
        u.pm = va ? apm : bpm; u.pn = va ? apn : bpn; u.ta = u.pm; u.tb = u.pn; u.k0 = va ? 0 : bk0; u.nt = va ? ntk : bnt; u.ks = va ? 0 : ks; u.sw = 0;
        return va || vb;
    }
};
struct FourierOrder {
    int c, lat;
    __device__ __forceinline__ bool next(int i, Unit& u) const {
        if (i != 0) return false;
        if (lat) { if (c >= 64) return false; u.pm = c; u.pn = 0; u.ta = c & 7; u.tb = c >> 3; u.k0 = 0; u.nt = 32; u.ks = 0; u.sw = 0; return true; }
        if (c < 64 || c >= 72) return false; u.pm = 64 + (c - 64); u.pn = 0; u.ta = 0; u.tb = c - 64; u.k0 = 0; u.nt = 8; u.ks = 0; u.sw = 0; return true;
    }
};


struct EpiF32 {
    static constexpr bool PERM = true;
    bf16_t* O; int ldc, ntfull;
    __device__ __forceinline__ void operator()(const f32x4 (&acc)[2][2][4][2], const Unit& u, int wr, int wc, int fr, int fq) const {
        const int rshift = (u.nt == ntfull) ? 0 : u.ks * 2048;
        const int row0 = u.pm * BM + rshift + wr * 64 + fr, col0 = u.pn * BM + wc * 32 + 8 * fq;
#pragma unroll
        for (int ai = 0; ai < 2; ++ai)
#pragma unroll
            for (int m = 0; m < 4; ++m) { bf16_t* rowp = O + (size_t)(row0 + ai * HALF + m * 16) * ldc + col0;
#pragma unroll
                for (int bj = 0; bj < 2; ++bj) { const f32x4 v0 = acc[ai][bj][m][0], v1 = acc[ai][bj][m][1];
                    u32x4 w; w.x = pk2(v0[0], v0[1]); w.y = pk2(v0[2], v0[3]); w.z = pk2(v1[0], v1[1]); w.w = pk2(v1[2], v1[3]);
                    *(u32x4*)(rowp + bj * HALF) = w; } }
    }
};
struct EpiBf16S {
    static constexpr bool PERM = true;
    bf16_t* O; int ldc; float sc;
    __device__ __forceinline__ void operator()(const f32x4 (&acc)[2][2][4][2], const Unit& u, int wr, int wc, int fr, int fq) const {
        const int row0 = u.pm * BM + wr * 64 + fr, col0 = u.pn * BM + wc * 32 + 8 * fq;
#pragma unroll
        for (int ai = 0; ai < 2; ++ai)
#pragma unroll
            for (int m = 0; m < 4; ++m) { bf16_t* rowp = O + (size_t)(row0 + ai * HALF + m * 16) * ldc + col0;
#pragma unroll
                for (int bj = 0; bj < 2; ++bj) { const f32x4 v0 = acc[ai][bj][m][0] * sc, v1 = acc[ai][bj][m][1] * sc;
                    u32x4 w; w.x = pk2v(v0[0], v0[1]); w.y = pk2v(v0[2], v0[3]); w.z = pk2v(v1[0], v1[1]); w.w = pk2v(v1[2], v1[3]);
                    *(u32x4*)(rowp + bj * HALF) = w; } }
    }
};
struct EpiP {
    static constexpr bool PERM = true;
    bf16_t* P; bf16_t *vtrl, *vtrc, *vtnl, *vtnc;
    __device__ __forceinline__ void operator()(const f32x4 (&acc)[2][2][4][2], const Unit& u, int wr, int wc, int fr, int fq) const {
        if (u.sw) {
            const bool lat = u.pm < 64;
            bf16_t* base; int ld, t0;
            if (lat) { base = (u.pn == 5 ? vtrl : vtnl) + (size_t)(u.pm >> 3) * 4 * 64 * 2048; ld = 2048; t0 = (u.pm & 7) * 256; }
            else     { base = (u.pn == 5 ? vtrc : vtnc) + (size_t)(u.pm - 64) * 4 * 64 * 256; ld = 256; t0 = 0; }
#pragma unroll
            for (int ai = 0; ai < 2; ++ai)
#pragma unroll
                for (int m = 0; m < 4; ++m) { bf16_t* rowp = base + (size_t)(ai * HALF + wr * 64 + m * 16 + fr) * ld + t0 + wc * 32 + 8 * fq;
#pragma unroll
                    for (int bj = 0; bj < 2; ++bj) { const f32x4 v0 = acc[ai][bj][m][0], v1 = acc[ai][bj][m][1];
                        u32x4 w; w.x = pk2(v0[0], v0[1]); w.y = pk2(v0[2], v0[3]); w.z = pk2(v1[0], v1[1]); w.w = pk2(v1[2], v1[3]);
                        *(u32x4*)(rowp + bj * HALF) = w; } }
            return;
        }
        const int row0 = u.pm * BM + wr * 64 + fr, col0 = u.pn * BM + wc * 32 + 8 * fq;
#pragma unroll
        for (int ai = 0; ai < 2; ++ai)
#pragma unroll
            for (int m = 0; m < 4; ++m) { bf16_t* rowp = P + (size_t)(row0 + ai * HALF + m * 16) * DIN + col0;
#pragma unroll
                for (int bj = 0; bj < 2; ++bj) { const f32x4 v0 = acc[ai][bj][m][0], v1 = acc[ai][bj][m][1];
                    u32x4 w; w.x = pk2(v0[0], v0[1]); w.y = pk2(v0[2], v0[3]); w.z = pk2(v1[0], v1[1]); w.w = pk2(v1[2], v1[3]);
                    *(u32x4*)(rowp + bj * HALF) = w; } }
    }
};
struct EpiUp {
    static constexpr bool PERM = true;
    bf16_t* G; float* uB; const float* cw;
    __device__ __forceinline__ void operator()(const f32x4 (&acc)[2][2][4][2], const Unit& u, int wr, int wc, int fr, int fq) const {
        const int ch0 = u.pn * HALF + wc * 32 + 8 * fq;
        const bool edge = (fr < 2) || (fr >= 14); const bool lo = fr < 2;
        const int erow = lo ? fr : fr - 12;
#pragma unroll
        for (int ai = 0; ai < 2; ++ai) {
            const int blk = u.pm * 4 + ai * 2 + wr, rowb = blk * 64;
            float* ua = uB + ((size_t)blk * 4 + erow) * NUP + ch0; float* ub = ua + DFF;
            bf16_t* gp = G + (size_t)(rowb + fr) * DFF + ch0;
#pragma unroll
            for (int n = 0; n < 2; ++n) {
                if (edge) {
                    const f32x4 ea = lo ? acc[ai][0][0][n] : acc[ai][0][3][n], eb = lo ? acc[ai][1][0][n] : acc[ai][1][3][n];
                    *(f32x4*)(ua + 4 * n) = ea; *(f32x4*)(ub + 4 * n) = eb;
                }
                unsigned ow[4][2];
#pragma unroll
                for (int jp = 0; jp < 2; ++jp) {
                    const float* cwp = cw + ch0 + 4 * n + 2 * jp;
                    const f32x2_t wa0 = *(const f32x2_t*)(cwp), wa1 = *(const f32x2_t*)(cwp + NUP), wa2 = *(const f32x2_t*)(cwp + 2 * NUP);
                    const f32x2_t wb0 = *(const f32x2_t*)(cwp + DFF), wb1 = *(const f32x2_t*)(cwp + NUP + DFF), wb2 = *(const f32x2_t*)(cwp + 2 * NUP + DFF);
#pragma unroll
                    for (int m = 0; m < 4; ++m) {
                        float gv[2];
#pragma unroll
                        for (int jj = 0; jj < 2; ++jj) {
                            const int j = 2 * jp + jj;
                            const float a = acc[ai][0][m][n][j], b = acc[ai][1][m][n][j];
                            const float ap = (m > 0) ? acc[ai][0][m - 1][n][j] : 0.f, bp = (m > 0) ? acc[ai][1][m - 1][n][j] : 0.f;
                            const float an = (m < 3) ? acc[ai][0][m + 1][n][j] : 0.f, bn = (m < 3) ? acc[ai][1][m + 1][n][j] : 0.f;
                            const float ua_ = dpp_ror1(fr == 15 ? ap : a), ub_ = dpp_ror1(fr == 15 ? bp : b);
                            const float da = dpp_ror15(fr == 0 ? an : a), db = dpp_ror15(fr == 0 ? bn : b);
                            const float ca = wa0[jj] * ua_ + wa1[jj] * a + wa2[jj] * da;
                            const float cb = wb0[jj] * ub_ + wb1[jj] * b + wb2[jj] * db;
                            gv[jj] = silu_f(ca) * cb;
                        }
                        ow[m][jp] = pk2(gv[0], gv[1]);
                    }
                    asm volatile("" ::: "memory");
                }
#pragma unroll
                for (int m = 0; m < 4; ++m) { u32x2 w; w.x = ow[m][0]; w.y = ow[m][1]; *(u32x2*)(gp + (size_t)(m * 16) * DFF + 4 * n) = w; }
                asm volatile("" ::: "memory");
            }
        }
    }
};

template <class Epi, class Sched, bool ALIGN_EPI = false, bool SP2 = false>
__device__ __forceinline__ void gemm_phase(LAS unsigned char* lds, const Gemm g, const Sched& S, const Epi& E, const int tidx) {
    const int tid = tidx, wid = __builtin_amdgcn_readfirstlane(tid >> 6), lane = tid & 63, wr = wid >> 2, wc = wid & 3, fr = lane & 15, fq = lane >> 4;
    const int K = g.K;
    unsigned voffA[2], voffB[2];
#pragma unroll
    for (int i = 0; i < 2; ++i) { int R, C; stage_rc(tid * 16 + i * 8192, R, C); const int Rb = Epi::PERM ? ((R & ~31) + perm32(R & 31)) : R;
        voffA[i] = (unsigned)(R * K + C) * 2u; voffB[i] = (unsigned)(Rb * K + C) * 2u; }
    const size_t kstep = (size_t)(BK * 2);
    const size_t hstepA = g.hstepA, hstepB = g.hstepB;
    const unsigned ldsw = (unsigned)wid * 1024u;
    const int aoff = lds_byte(wr * 64 + fr, fq * 8), boff = lds_byte(wc * 32 + fr, fq * 8);
#define PG8_SA(b, h) (((b) * 2 + (h)) * HTB)
#define PG8_SB(b, h) ((4 + (b) * 2 + (h)) * HTB)
#define PG8_STAGE(bufoff, gbase, voff) do { _Pragma("unroll") for (int _i = 0; _i < 2; ++_i) \
        __builtin_amdgcn_global_load_lds((const unsigned*)((const char*)(gbase) + (voff)[_i]), (LAS unsigned*)(lds + (bufoff) + ldsw + _i * 8192), 16, 0, 0); } while (0)
#define PG8_LDA(dst, b, h) do { _Pragma("unroll") for (int m = 0; m < 4; ++m) _Pragma("unroll") for (int k = 0; k < 2; ++k) dst[m][k] = *(const LAS bf16x8*)(lds + PG8_SA(b, h) + aoff + m * 2048 + k * 1024); } while (0)
#define PG8_LDB(dst, b, h) do { _Pragma("unroll") for (int n = 0; n < 2; ++n) _Pragma("unroll") for (int k = 0; k < 2; ++k) dst[n][k] = *(const LAS bf16x8*)(lds + PG8_SB(b, h) + boff + n * 2048 + k * 1024); } while (0)
#define PG8_MMA(ai, bj, At, Bt) do { __builtin_amdgcn_s_setprio(1); _Pragma("unroll") for (int m = 0; m < 4; ++m) _Pragma("unroll") for (int n = 0; n < 2; ++n) _Pragma("unroll") for (int k = 0; k < 2; ++k) \
        acc[ai][bj][m][n] = __builtin_amdgcn_mfma_f32_16x16x32_bf16(Bt[n][k], At[m][k], acc[ai][bj][m][n], 0, 0, 0); __builtin_amdgcn_s_setprio(0); } while (0)
#define PG8_WAIT_V(n) asm volatile("s_waitcnt vmcnt(" #n ")" ::: "memory")
#define PG8_WAIT_L(n) asm volatile("s_waitcnt lgkmcnt(" #n ")" ::: "memory")
#define PG8_BAR __builtin_amdgcn_s_barrier()
#define PG8_SCHED __builtin_amdgcn_sched_barrier(0)
    Unit cur, nxt; int ui = 0;
    if (!S.next(0, cur)) return;
    f32x4 acc[2][2][4][2];
#pragma unroll
    for (int a = 0; a < 2; ++a)
#pragma unroll
        for (int b = 0; b < 2; ++b)
#pragma unroll
            for (int m = 0; m < 4; ++m)
#pragma unroll
                for (int n = 0; n < 2; ++n) acc[a][b][m][n] = (f32x4){0.f, 0.f, 0.f, 0.f};
    bf16x8 At[4][2], B0[2][2], B1[2][2];
#define PG8_UA(u) ((u).sw ? (const char*)g.Bt + (size_t)(u).tb * g.tstepB + (size_t)(u).k0 * (BK * 2) : (const char*)g.A + (size_t)(u).ta * g.tstepA + (size_t)(u).k0 * (BK * 2))
#define PG8_UB(u) ((u).sw ? (const char*)g.A + (size_t)(u).ta * g.tstepA + (size_t)(u).k0 * (BK * 2) : (const char*)g.Bt + (size_t)(u).tb * g.tstepB + (size_t)(u).k0 * (BK * 2))
    const char* cA = PG8_UA(cur); const char* cB = PG8_UB(cur);
    if constexpr (SP2) {
        PG8_STAGE(PG8_SB(0, 0), cB, voffB); PG8_STAGE(PG8_SB(0, 1), cB + hstepB, voffB); PG8_STAGE(PG8_SA(0, 0), cA, voffA); PG8_STAGE(PG8_SA(0, 1), cA + hstepA, voffA);
        if (wr == 1) PG8_BAR;
        PG8_WAIT_V(2); PG8_BAR;
        PG8_STAGE(PG8_SB(1, 0), cB + kstep, voffB); PG8_STAGE(PG8_SA(1, 0), cA + kstep, voffA); PG8_STAGE(PG8_SB(1, 1), cB + hstepB + kstep, voffB);
        PG8_WAIT_V(6); PG8_BAR;
    } else {
        PG8_STAGE(PG8_SB(0, 0), cB, voffB); PG8_STAGE(PG8_SA(0, 0), cA, voffA); PG8_STAGE(PG8_SB(0, 1), cB + hstepB, voffB); PG8_STAGE(PG8_SA(0, 1), cA + hstepA, voffA);
        if (wr == 1) PG8_BAR;
        PG8_WAIT_V(4); PG8_BAR;
        PG8_STAGE(PG8_SB(1, 0), cB + kstep, voffB); PG8_STAGE(PG8_SA(1, 0), cA + kstep, voffA); PG8_STAGE(PG8_SB(1, 1), cB + hstepB + kstep, voffB);
        PG8_WAIT_V(6); PG8_BAR;
    }
    for (;;) {
        const bool has_next = S.next(ui + 1, nxt);
        const char* nA = has_next ? PG8_UA(nxt) : cA; const char* nB = has_next ? PG8_UB(nxt) : cB;
        const int nt = cur.nt;
        for (int t = 0; t < nt; t += 2) {
            const bool last = (t == nt - 2);
            const char* a1 = cA + (size_t)(t + 1) * kstep;
            const char* a2 = last ? nA : cA + (size_t)(t + 2) * kstep; const char* b2 = last ? nB : cB + (size_t)(t + 2) * kstep;
            const char* a3 = a2 + kstep; const char* b3 = b2 + kstep;
            if constexpr (SP2) {
            PG8_LDB(B0, 0, 0); PG8_LDB(B1, 0, 1); PG8_SCHED; PG8_LDA(At, 0, 0); PG8_STAGE(PG8_SA(1, 1), a1 + hstepA, voffA);
            PG8_WAIT_V(8); PG8_WAIT_L(0); PG8_BAR; PG8_MMA(0, 0, At, B0); PG8_MMA(0, 1, At, B1); PG8_BAR; PG8_SCHED;
            PG8_LDA(At, 0, 1); PG8_STAGE(PG8_SB(0, 0), b2, voffB); PG8_STAGE(PG8_SB(0, 1), b2 + hstepB, voffB); PG8_STAGE(PG8_SA(0, 0), a2, voffA);
            PG8_WAIT_V(8); PG8_WAIT_L(0); PG8_BAR; PG8_MMA(1, 0, At, B0); PG8_MMA(1, 1, At, B1); PG8_BAR; PG8_SCHED;
            PG8_LDB(B0, 1, 0); PG8_LDB(B1, 1, 1); PG8_SCHED; PG8_LDA(At, 1, 0); PG8_STAGE(PG8_SA(0, 1), a2 + hstepA, voffA);
            PG8_WAIT_V(8); PG8_WAIT_L(0); PG8_BAR; PG8_MMA(0, 0, At, B0); PG8_MMA(0, 1, At, B1); PG8_BAR; PG8_SCHED;
            PG8_LDA(At, 1, 1); PG8_STAGE(PG8_SB(1, 0), b3, voffB); PG8_STAGE(PG8_SB(1, 1), b3 + hstepB, voffB); PG8_STAGE(PG8_SA(1, 0), a3, voffA);
            PG8_WAIT_V(8); PG8_WAIT_L(0); PG8_BAR; PG8_MMA(1, 0, At, B0); PG8_MMA(1, 1, At, B1); PG8_BAR; PG8_SCHED;
            } else {
            PG8_LDB(B0, 0, 0); PG8_SCHED; PG8_LDA(At, 0, 0); PG8_STAGE(PG8_SA(1, 1), a1 + hstepA, voffA);
            PG8_WAIT_L(8); PG8_BAR; PG8_WAIT_L(0); PG8_MMA(0, 0, At, B0); PG8_BAR; PG8_SCHED;
            PG8_LDB(B1, 0, 1); PG8_STAGE(PG8_SB(0, 0), b2, voffB);
            PG8_BAR; PG8_WAIT_L(0); PG8_MMA(0, 1, At, B1); PG8_BAR;
            PG8_LDA(At, 0, 1); PG8_STAGE(PG8_SA(0, 0), a2, voffA);
            PG8_BAR; PG8_WAIT_L(0); PG8_MMA(1, 0, At, B0); PG8_BAR; PG8_SCHED;
            PG8_STAGE(PG8_SB(0, 1), b2 + hstepB, voffB);
            PG8_WAIT_V(6); PG8_BAR; PG8_MMA(1, 1, At, B1); PG8_BAR;
            PG8_LDB(B0, 1, 0); PG8_SCHED; PG8_LDA(At, 1, 0); PG8_STAGE(PG8_SA(0, 1), a2 + hstepA, voffA);
            PG8_WAIT_L(8); PG8_BAR; PG8_WAIT_L(0); PG8_MMA(0, 0, At, B0); PG8_BAR; PG8_SCHED;
            PG8_LDB(B1, 1, 1); PG8_STAGE(PG8_SB(1, 0), b3, voffB);
            PG8_BAR; PG8_WAIT_L(0); PG8_MMA(0, 1, At, B1); PG8_BAR;
            PG8_LDA(At, 1, 1); PG8_STAGE(PG8_SA(1, 0), a3, voffA);
            PG8_BAR; PG8_WAIT_L(0); PG8_MMA(1, 0, At, B0); PG8_BAR; PG8_SCHED;
            PG8_STAGE(PG8_SB(1, 1), b3 + hstepB, voffB);
            PG8_WAIT_V(6); PG8_BAR; PG8_MMA(1, 1, At, B1); PG8_BAR;
            }
        }
        if constexpr (ALIGN_EPI) { if (wr == 0) PG8_BAR; }
        E(acc, cur, wr, wc, fr, fq);
        if (!has_next) break;
#pragma unroll
        for (int a = 0; a < 2; ++a)
#pragma unroll
            for (int b = 0; b < 2; ++b)
#pragma unroll
                for (int m = 0; m < 4; ++m)
#pragma unroll
                    for (int n = 0; n < 2; ++n) acc[a][b][m][n] = (f32x4){0.f, 0.f, 0.f, 0.f};
        cur = nxt; cA = nA; cB = nB; ++ui;
        if constexpr (ALIGN_EPI) { if (wr == 1) PG8_BAR; }
    }
    PG8_WAIT_V(0);
    if constexpr (!ALIGN_EPI) { if (wr == 0) PG8_BAR; }
    PG8_BAR;
#undef PG8_SA
#undef PG8_SB
#undef PG8_STAGE
#undef PG8_LDA
#undef PG8_LDB
#undef PG8_MMA
#undef PG8_WAIT_V
#undef PG8_WAIT_L
#undef PG8_BAR
#undef PG8_SCHED
}
}

#define XB_TMO      128
#define XB_XCNT(j)  (256  + 64 * (j))
#define XB_XSUB(j)  (1280 + 64 * (j))
#define XB_XGEN(j)  (2304 + 64 * (j))
#define XB_TOP      3328
#define XB_TOPGEN   3392
#define XCD_BAR_WORDS 3456
#define XB_SPIN_CAP (1u << 18)

__device__ __forceinline__ unsigned xb_ld(unsigned* p)              { return __hip_atomic_load(p, __ATOMIC_RELAXED, __HIP_MEMORY_SCOPE_AGENT); }
__device__ __forceinline__ unsigned xb_add(unsigned* p, unsigned v) { return __hip_atomic_fetch_add(p, v, __ATOMIC_RELAXED, __HIP_MEMORY_SCOPE_AGENT); }
__device__ __forceinline__ unsigned xb_xcc_id() { return (unsigned)__builtin_amdgcn_s_getreg((3 << 11) | 20) & 0xFu; }
#define XB_SPIN(cond, bar) do { unsigned _sp = 0; while (cond) { __builtin_amdgcn_s_sleep(1); \
    if ((++_sp & 255u) == 0u) { if (xb_ld(&(bar)[XB_TMO])) break; if (_sp > XB_SPIN_CAP) { atomicAdd(&(bar)[XB_TMO], 1u); break; } } } } while (0)

struct XcdBarrier {
    unsigned* bar; unsigned x;
    volatile LAS unsigned* st;
};

__device__ __forceinline__ XcdBarrier xcd_barrier_post(unsigned* bar, volatile LAS unsigned* st) {
    XcdBarrier b; b.bar = bar; b.x = xb_xcc_id(); b.st = st;
    if (threadIdx.x == 0) (void)xb_add(&bar[XB_XCNT(b.x)], 1u);
    return b;
}
__device__ __forceinline__ void xcd_barrier_complete(unsigned* bar, unsigned x, unsigned& nloc, unsigned& nx) {
    const unsigned G = gridDim.x * gridDim.y * gridDim.z;
    unsigned sum, cnt, mine, sp = 0u;
    for (;;) {
        sum = 0u; cnt = 0u; mine = 0u;
#pragma unroll
        for (unsigned j = 0; j < 16; ++j) { const unsigned c = xb_ld(&bar[XB_XCNT(j)]); sum += c; cnt += (c > 0u) ? 1u : 0u; mine = (j == x) ? c : mine; }
        if (sum == G) break;
        __builtin_amdgcn_s_sleep(1);
        if ((++sp & 255u) == 0u) { if (xb_ld(&bar[XB_TMO])) break; if (sp > XB_SPIN_CAP) { atomicAdd(&bar[XB_TMO], 1u); break; } }
    }
    nloc = mine > 0u ? mine : 1u; nx = cnt > 0u ? cnt : 1u;
}

__device__ __forceinline__ void xcd_barrier(const XcdBarrier& b) {
    asm volatile("s_waitcnt vmcnt(0)" ::: "memory");
    __syncthreads();
    if (threadIdx.x == 0) {
        unsigned* bar = b.bar;
        __builtin_amdgcn_s_waitcnt(0);
        unsigned nloc = b.st[0], nx = b.st[1];
        if (nloc == 0u) { xcd_barrier_complete(bar, b.x, nloc, nx); b.st[0] = nloc; b.st[1] = nx; }
        const unsigned old = xb_add(&bar[XB_XSUB(b.x)], 1u);
        const unsigned gen = old / nloc;
        if (old + 1u == (gen + 1u) * nloc) {
            __builtin_amdgcn_fence(__ATOMIC_RELEASE, "agent");
            asm volatile("s_waitcnt vmcnt(0)" ::: "memory");
            const unsigned og = xb_add(&bar[XB_TOP], 1u);
            const unsigned tg = og / nx;
            if (og + 1u == (tg + 1u) * nx) xb_add(&bar[XB_TOPGEN], 1u);
            else XB_SPIN(xb_ld(&bar[XB_TOPGEN]) == tg, bar);
            __builtin_amdgcn_fence(__ATOMIC_ACQUIRE, "agent");
            xb_add(&bar[XB_XGEN(b.x)], 1u);
            asm volatile("s_waitcnt vmcnt(0)" ::: "memory");
        } else {
            XB_SPIN(xb_ld(&bar[XB_XGEN(b.x)]) == gen, bar);
            __builtin_amdgcn_fence(__ATOMIC_ACQUIRE, "agent");
            asm volatile("s_waitcnt vmcnt(0)" ::: "memory");
        }
    }
    __syncthreads();
}

#ifndef PHMASK
#define PHMASK 0xFFFFF
#endif
#define PHON(k) ((PHMASK >> (k)) & 1)
struct Args { const float* in[18]; float* out; unsigned char* ws; };
enum { I_X = 0, I_C, I_CTX, I_CCTX, I_WMOD, I_BMOD, I_GPREMIX, I_GPOSTMIX, I_GPREFFN, I_GPOSTFFN, I_WIN, I_WOUT, I_CONVW, I_RETDECAY, I_RPB, I_WUP, I_FFNCONVW, I_WDOWN };

DI void transpose_item(const float* W, int K, int N, bf16_t* WT, LAS float* scr, int item, int lane) {
    const int nblk = N / 32, kb = item / nblk, nb = item % nblk, k0 = 64 * kb, n0 = 32 * nb;
#pragma unroll 8
    for (int i = 0; i < 32; ++i) { const int kk = 2 * i + (lane >> 5); scr[kk * 33 + (lane & 31)] = __builtin_nontemporal_load(W + (size_t)(k0 + kk) * N + n0 + (lane & 31)); }
    asm volatile("s_waitcnt lgkmcnt(0)" ::: "memory");
    const int c = lane & 7;
#pragma unroll
    for (int j = 0; j < 4; ++j) { const int n = (lane >> 3) + 8 * j; const LAS float* s = scr + (8 * c) * 33 + n;
        u32x4 o; o.x = pk2(s[0 * 33], s[1 * 33]); o.y = pk2(s[2 * 33], s[3 * 33]); o.z = pk2(s[4 * 33], s[5 * 33]); o.w = pk2(s[6 * 33], s[7 * 33]);
        *(u32x4*)(WT + (size_t)(n0 + n) * K + k0 + 8 * c) = o; }
    asm volatile("s_waitcnt lgkmcnt(0)" ::: "memory");
}
DI void convert_weight(const float* W, int K, int N, bf16_t* WT, LAS unsigned char* L, int gw, int ngw, int lane, int wave) {
    LAS float* scr = (LAS float*)(L + wave * 8704);
    const int nitems = (K / 64) * (N / 32);
    for (int it = gw; it < nitems; it += ngw) transpose_item(W, K, N, WT, scr, it, lane);
}

struct ConvJob { const float* W; bf16_t* WT; int K, N; };
template <int NJ>
DI void filler_convert(const ConvJob (&jobs)[NJ], unsigned* ctr, LAS unsigned char* L, int tid, int lane, int wave) {
    int cnt[NJ], total = 0;
#pragma unroll
    for (int j = 0; j < NJ; ++j) { cnt[j] = jobs[j].W ? (jobs[j].K / 64) * (jobs[j].N / 32) : 0; total += cnt[j]; }
    LAS int* bw = (LAS int*)(L + 140000);
    LAS float* scr = (LAS float*)(L + wave * 8704);
    for (;;) {
        __syncthreads();
        if (tid == 0) *bw = (int)atomicAdd(ctr, 8u);
        __syncthreads();
        const int base = __builtin_amdgcn_readfirstlane(*bw);
        if (base >= total) break;
        int it = base + wave;
        if (it < total) {
#pragma unroll
            for (int j = 0; j < NJ; ++j) { if (it >= 0 && it < cnt[j]) transpose_item(jobs[j].W, jobs[j].K, jobs[j].N, jobs[j].WT, scr, it, lane); it -= cnt[j]; }
        }
    }
}
constexpr size_t WOFF_IN = 0, WOFF_OUT = (size_t)DIN * DM, WOFF_UP = WOFF_OUT + (size_t)DM * DM, WOFF_DN = WOFF_UP + (size_t)NUP * DM;
static_assert(WS_WOUT - WS_WIN == WOFF_OUT * 2 && WS_WUP - WS_WIN == WOFF_UP * 2 && WS_WDN - WS_WIN == WOFF_DN * 2, "weight set layout");
#define WSET(l_) ((bf16_t*)(((l_) & 1) ? (unsigned char*)a.out : ws + WS_WIN))

template <class ArgsT> DI void mods_phase(const ArgsT& a, LAS unsigned char* L, float* mods, const int tidx) {
    LAS float* sc = (LAS float*)L;
    LAS float* red = (LAS float*)(L + 9 * 1024 * 4);
    const int tid = tidx, lane = tid & 63, wave = tid >> 6;
    for (int i = tid; i < 9 * 1024; i += NTHREADS) { const float v = (i < 8192) ? a.in[I_C][i] : a.in[I_CCTX][i - 8192]; sc[i] = silu_f(v); }
    __syncthreads();
    for (int it = blockIdx.x; it < 4 * 48; it += gridDim.x) {
        const int l = it / 48, n0 = (it % 48) * 128;
        const float* W = a.in[I_WMOD] + (size_t)l * 1024 * 6144 + n0 + lane * 2;
        f32x2_t acc[9];
#pragma unroll
        for (int i = 0; i < 9; ++i) acc[i] = (f32x2_t){0.f, 0.f};
#pragma unroll 1
        for (int k0 = wave * 128; k0 < wave * 128 + 128; k0 += 8) {
            f32x2_t w[8];
#pragma unroll
            for (int kk = 0; kk < 8; ++kk) w[kk] = __builtin_nontemporal_load((const f32x2_t*)(W + (size_t)(k0 + kk) * 6144));
#pragma unroll
            for (int kk = 0; kk < 8; ++kk)
#pragma unroll
                for (int i = 0; i < 9; ++i) acc[i] += sc[i * 1024 + k0 + kk] * w[kk];
        }
#pragma unroll
        for (int i = 0; i < 9; ++i) *(LAS f32x2_t*)(red + (wave * 9 + i) * 128 + lane * 2) = acc[i];
        __syncthreads();
        for (int o = tid; o < 9 * 128; o += NTHREADS) { const int i = o >> 7, c = o & 127; float s = 0.f;
#pragma unroll
            for (int w = 0; w < 8; ++w) s += red[(w * 9 + i) * 128 + c];
            mods[(size_t)(l * 9 + i) * 6144 + n0 + c] = s + a.in[I_BMOD][l * 6144 + n0 + c]; }
        __syncthreads();
    }
}

DI void tables_phase(unsigned char* ws, const int tidx) {
    const size_t gt = (size_t)blockIdx.x * NTHREADS + tidx, ngt = (size_t)gridDim.x * NTHREADS;
    bf16_t* dft = (bf16_t*)(ws + WS_DFT);
    for (size_t i = gt; i < (size_t)2048 * 2048 / 8; i += ngt) {
        const int k = (int)(i / 256), n8 = (int)(i % 256) * 8; float v[8];
#pragma unroll
        for (int j = 0; j < 8; ++j) { const int nn = n8 + j, n = nn & 1023; const int m = (k * n) & 2047; const float x = (float)m * (1.0f / 1024.0f);
            v[j] = (nn < 1024) ? cospif(x) : (n == 0 ? ((k & 1) ? -1.0f : 1.0f) : -sinpif(x)); }
        u32x4 o; o.x = pk2(v[0], v[1]); o.y = pk2(v[2], v[3]); o.z = pk2(v[4], v[5]); o.w = pk2(v[6], v[7]);
        *(u32x4*)(dft + i * 8) = o;
    }
    bf16_t* dftc = (bf16_t*)(ws + WS_DFTC);
    for (size_t i = gt; i < (size_t)256 * 512 / 8; i += ngt) {
        const int k = (int)(i / 64), n8 = (int)(i % 64) * 8; float v[8];
#pragma unroll
        for (int j = 0; j < 8; ++j) { const int nn = n8 + j, n = nn & 255; const int m = (k * n) & 255; const float x = (float)m * (1.0f / 128.0f); v[j] = (nn < 256) ? cospif(x) : -sinpif(x); }
        u32x4 o; o.x = pk2(v[0], v[1]); o.y = pk2(v[2], v[3]); o.z = pk2(v[4], v[5]); o.w = pk2(v[6], v[7]);
        *(u32x4*)(dftc + i * 8) = o;
    }
    bf16_t* cm = (bf16_t*)(ws + WS_CMAT);
    for (size_t i = gt; i < 128 * 64; i += ngt) { const int jr = (int)i / 64, c = (int)i % 64, j = jr & 63; const int m = (j * c) & 63; const float x = (float)m * (1.0f / 32.0f);
        const float v = (jr < 64) ? cospif(x) : sinpif(x); cm[i] = (bf16_t)(pk2(v, 0.f) & 0xffffu); }
    float* rc = (float*)(ws + WS_ROPE); float* rs = rc + 2048 * 32;
    for (size_t i = gt; i < 2048 * 32; i += ngt) { const int t = (int)i / 32, f = (int)i % 32; const float inv = powf(10000.0f, -(float)(f & 15) / 16.0f);
        const float pos = (f < 16) ? (float)(t / 64) : (float)(t % 64); const float ang = pos * inv; rc[i] = cosf(ang); rs[i] = sinf(ang); }
}

template <bool XIN16, bool XOUT16>
DI void rowwise_phase(const float* xin_lat, const float* xin_ctx, float* xout_lat, bf16_t* xb, const bf16_t* o, const float* gpost, const float* mod_gate  ,
                      const float* gpre, const float* mod_sc, const float* mod_sh, bf16_t* hout, int nrows, const int tidx) {
    const bool aff = (gridDim.x % 8) == 0;
    const int lane = tidx & 63, xcd = aff ? (int)(blockIdx.x & 7) : 0;
    const int gw = aff ? (int)(blockIdx.x >> 3) * 8 + (tidx >> 6) : (int)blockIdx.x * 8 + (tidx >> 6), ngw = aff ? (int)(gridDim.x >> 3) * 8 : (int)gridDim.x * 8;
    const int nloc = aff ? (nrows > TL ? 2304 : 2048) : nrows;
    constexpr int NR = 3;
    for (int r0 = gw; r0 < nloc; r0 += NR * ngw) {
        int rr[NR]; bool ok[NR];
#pragma unroll
        for (int k = 0; k < NR; ++k) { int i = r0 + k * ngw; ok[k] = i < nloc; if (!ok[k]) i = r0; rr[k] = !aff ? i : (i < 2048 ? xcd * 2048 + i : TL + xcd * 256 + (i - 2048)); }
        f32x4 x[NR][4], ov[NR][4];
#pragma unroll
        for (int k = 0; k < NR; ++k) {
            const int r = rr[k]; const bool lat = r < TL;
            if (XIN16) {
#pragma unroll
                for (int j = 0; j < 4; ++j) { const u32x2 w0 = *(const u32x2*)(xb + (size_t)r * DM + lane * 4 + 256 * j); x[k][j] = (f32x4){hlo(w0.x), hhi(w0.x), hlo(w0.y), hhi(w0.y)}; }
            } else {
                const float* xi = lat ? xin_lat + (size_t)r * DM : xin_ctx + (size_t)(r - TL) * DM;
#pragma unroll
                for (int j = 0; j < 4; ++j) x[k][j] = __builtin_nontemporal_load((const f32x4*)(xi + lane * 4 + 256 * j));
            }
            if (o) {
#pragma unroll
                for (int j = 0; j < 4; ++j) { const u32x2 w0 = __builtin_nontemporal_load((const u32x2*)(o + (size_t)r * DM + lane * 4 + 256 * j)); ov[k][j] = (f32x4){bflo(w0.x), bfhi(w0.x), bflo(w0.y), bfhi(w0.y)}; }
                if (!lat) {
#pragma unroll
                    for (int ks = 1; ks < 4; ++ks)
#pragma unroll
                        for (int j = 0; j < 4; ++j) { const u32x2 wk = __builtin_nontemporal_load((const u32x2*)(o + (size_t)(r + ks * TC) * DM + lane * 4 + 256 * j)); ov[k][j] += (f32x4){bflo(wk.x), bfhi(wk.x), bflo(wk.y), bfhi(wk.y)}; }
                }
            }
        }
#pragma unroll
        for (int k = 0; k < NR; ++k) {
            const int r = rr[k]; const bool lat = r < TL; const int bi = lat ? (r >> 11) : 8;
            if (o) {
                float ss = 0.f;
#pragma unroll
                for (int j = 0; j < 4; ++j) ss += ov[k][j].x * ov[k][j].x + ov[k][j].y * ov[k][j].y + ov[k][j].z * ov[k][j].z + ov[k][j].w * ov[k][j].w;
                const float rstd = rsqrtf(wave_sum(ss) * (1.0f / DM) + EPSV);
#pragma unroll
                for (int j = 0; j < 4; ++j) { const f32x4 gp = *(const f32x4*)(gpost + lane * 4 + 256 * j), gt = *(const f32x4*)(mod_gate + (size_t)bi * 6144 + lane * 4 + 256 * j);
                    x[k][j] = x[k][j] + gt * (ov[k][j] * rstd * gp); }
            }
            if (XOUT16) {
                if (ok[k]) {
#pragma unroll
                    for (int j = 0; j < 4; ++j) { u32x2 w; w.x = pkh2(x[k][j].x, x[k][j].y); w.y = pkh2(x[k][j].z, x[k][j].w); __builtin_nontemporal_store(w, (u32x2*)(xb + (size_t)r * DM + lane * 4 + 256 * j)); }
                }
            } else if (xout_lat && ok[k] && lat) {
#pragma unroll
                for (int j = 0; j < 4; ++j) __builtin_nontemporal_store(x[k][j], (f32x4*)(xout_lat + (size_t)r * DM + lane * 4 + 256 * j));
            }
            if (hout) {
                float ss = 0.f;
#pragma unroll
                for (int j = 0; j < 4; ++j) ss += x[k][j].x * x[k][j].x + x[k][j].y * x[k][j].y + x[k][j].z * x[k][j].z + x[k][j].w * x[k][j].w;
                const float rstd = rsqrtf(wave_sum(ss) * (1.0f / DM) + EPSV);
                if (ok[k]) {
#pragma unroll
                    for (int j = 0; j < 4; ++j) { const f32x4 gp = *(const f32x4*)(gpre + lane * 4 + 256 * j), sc = *(const f32x4*)(mod_sc + (size_t)bi * 6144 + lane * 4 + 256 * j), sh = *(const f32x4*)(mod_sh + (size_t)bi * 6144 + lane * 4 + 256 * j);
                        const f32x4 hv = (x[k][j] * rstd * gp) * (1.0f + sc) + sh;
                        u32x2 w; w.x = pk2(hv.x, hv.y); w.y = pk2(hv.z, hv.w);
                        *(u32x2*)(hout + (size_t)r * DM + lane * 4 + 256 * j) = w; }
                }
            }
        }
    }
}

DI void chdft_phase(const bf16_t* p, const bf16_t* cmat, bf16_t* zt, bf16_t* zct, bool with_ctx, int gw, int ngw, int lane) {
    const int nlat = TL / 32, ntask = nlat + (with_ctx ? TC / 16 : 0), l15 = lane & 15, q = lane >> 4;
    for (int task = gw; task < ntask; task += ngw) {
        if (task < nlat) {
            const int b = task >> 6, n0 = (task & 63) * 16;
            bf16_t* zb = zt + (size_t)b * 256 * 2048;
            const bf16_t* src = p + (size_t)(b * 2048 + n0 + l15) * DIN + 1792 + q * 8;
            const bf16_t* srm = p + (size_t)(b * 2048 + 2048 - n0 - l15) * DIN + 1792 + q * 8;
            const bf16_t* srh = p + (size_t)(b * 2048 + 1024 + l15) * DIN + 1792 + q * 8;
            const bool first = (n0 == 0);
#pragma unroll 1
            for (int g = 0; g < 4; ++g) {
                const bf16x8 a0 = ld8(src + g * 64), a1 = ld8(src + g * 64 + 32), m0 = ld8(srm + g * 64), m1 = ld8(srm + g * 64 + 32);
                bf16x8 h0 = a0, h1 = a1; if (first) { h0 = ld8(srh + g * 64); h1 = ld8(srh + g * 64 + 32); }
                float sp[4] = {0.f, 0.f, 0.f, 0.f};
#pragma unroll
                for (int jt = 0; jt < 8; ++jt) {
                    const bf16x8 c0 = ld8(cmat + (jt * 16 + l15) * 64 + q * 8), c1 = ld8(cmat + (jt * 16 + l15) * 64 + 32 + q * 8);
                    f32x4 acc = {0.f, 0.f, 0.f, 0.f}, acm = {0.f, 0.f, 0.f, 0.f};
                    acc = mfma16(a0, c0, acc); acc = mfma16(a1, c1, acc);
                    acm = mfma16(m0, c0, acm); acm = mfma16(m1, c1, acm);
                    if (first && q == 0) acm[0] = 0.f;
                    f32x4 v = (jt < 4) ? acc + acm : acc - acm;
                    if (first) {
                        if (jt < 4) { f32x4 ah = {0.f, 0.f, 0.f, 0.f}; ah = mfma16(h0, c0, ah); ah = mfma16(h1, c1, ah); sp[jt & 3] = ah[0]; }
                        else if (q == 0) v[0] = sp[jt & 3];
                    }
                    u32x2 w; w.x = pk2(v[0], v[1]); w.y = pk2(v[2], v[3]);
                    *(u32x2*)(zb + (size_t)(g * 64 + (jt & 3) * 16 + l15) * 2048 + (jt >> 2) * 1024 + n0 + q * 4) = w;
                }
            }
        } else {
            const int tok0 = TL + (task - nlat) * 16;
            const int b = (tok0 - TL) >> 8; bf16_t* zb = zct + (size_t)b * 256 * 512; const int n0 = (tok0 - TL) & 255;
            const bf16_t* src = p + (size_t)(tok0 + l15) * DIN + 1792 + q * 8;
#pragma unroll
            for (int g = 0; g < 4; ++g) {
                const bf16x8 a0 = ld8(src + g * 64), a1 = ld8(src + g * 64 + 32);
#pragma unroll
                for (int jt = 0; jt < 8; ++jt) {
                    const bf16x8 c0 = ld8(cmat + (jt * 16 + l15) * 64 + q * 8), c1 = ld8(cmat + (jt * 16 + l15) * 64 + 32 + q * 8);
                    f32x4 acc = {0.f, 0.f, 0.f, 0.f};
                    acc = mfma16(a0, c0, acc); acc = mfma16(a1, c1, acc);
                    u32x2 w; w.x = pk2(acc[0], acc[1]); w.y = pk2(acc[2], acc[3]);
                    *(u32x2*)(zb + (size_t)(g * 64 + (jt & 3) * 16 + l15) * 512 + (jt >> 2) * 256 + n0 + q * 4) = w;
                }
            }
        }
    }
}
DI void sconv_item(const bf16_t* p, const float* cw  , bf16_t* y, int row0  , const int tidx) {
#pragma unroll 2
    for (int idx = row0 * 32 + tidx; idx < (row0 + 64) * 32; idx += NTHREADS) {
        const int r = idx >> 5, c0 = (idx & 31) * 8;
        int t, len; if (r < TL) { t = r & 2047; len = 2048; } else { t = (r - TL) & 255; len = 256; }
        const bf16_t* pr = p + (size_t)r * DIN + c0;
        float s[8];
#pragma unroll
        for (int e = 0; e < 8; ++e) s[e] = 0.f;
#pragma unroll
        for (int d = -1; d <= 1; ++d) {
            if (t + d < 0 || t + d >= len) continue;
            const u32x4 uu = *(const u32x4*)(pr + (long)d * DIN), gg = *(const u32x4*)(pr + (long)d * DIN + 512);
            const f32x4 w0 = *(const f32x4*)(cw + (d + 1) * 256 + c0), w1 = *(const f32x4*)(cw + (d + 1) * 256 + c0 + 4);
            s[0] += w0[0] * bflo(uu.x) * bflo(gg.x); s[1] += w0[1] * bfhi(uu.x) * bfhi(gg.x);
            s[2] += w0[2] * bflo(uu.y) * bflo(gg.y); s[3] += w0[3] * bfhi(uu.y) * bfhi(gg.y);
            s[4] += w1[0] * bflo(uu.z) * bflo(gg.z); s[5] += w1[1] * bfhi(uu.z) * bfhi(gg.z);
            s[6] += w1[2] * bflo(uu.w) * bflo(gg.w); s[7] += w1[3] * bfhi(uu.w) * bfhi(gg.w);
        }
        const u32x4 bb = *(const u32x4*)(pr + 256);
        u32x4 o; o.x = pk2(s[0] * bflo(bb.x), s[1] * bfhi(bb.x)); o.y = pk2(s[2] * bflo(bb.y), s[3] * bfhi(bb.y));
        o.z = pk2(s[4] * bflo(bb.z), s[5] * bfhi(bb.z)); o.w = pk2(s[6] * bflo(bb.w), s[7] * bfhi(bb.w));
        *(u32x4*)(y + (size_t)r * DM + c0) = o;
    }
}
DI void load_rope16(const bf16_t* src  , int seg, bool lat, const float* rc, const float* rs, int tpos, float (&v)[16]) {
    const u32x4 o0 = *(const u32x4*)(src + seg * 16), o1 = *(const u32x4*)(src + seg * 16 + 8);
    v[0] = bflo(o0.x); v[1] = bfhi(o0.x); v[2] = bflo(o0.y); v[3] = bfhi(o0.y); v[4] = bflo(o0.z); v[5] = bfhi(o0.z); v[6] = bflo(o0.w); v[7] = bfhi(o0.w);
    v[8] = bflo(o1.x); v[9] = bfhi(o1.x); v[10] = bflo(o1.y); v[11] = bfhi(o1.y); v[12] = bflo(o1.z); v[13] = bfhi(o1.z); v[14] = bflo(o1.w); v[15] = bfhi(o1.w);
    if (lat) {
        const u32x4 p0 = *(const u32x4*)(src + (seg ^ 2) * 16), p1 = *(const u32x4*)(src + (seg ^ 2) * 16 + 8);
        float pv[16];
        pv[0] = bflo(p0.x); pv[1] = bfhi(p0.x); pv[2] = bflo(p0.y); pv[3] = bfhi(p0.y); pv[4] = bflo(p0.z); pv[5] = bfhi(p0.z); pv[6] = bflo(p0.w); pv[7] = bfhi(p0.w);
        pv[8] = bflo(p1.x); pv[9] = bfhi(p1.x); pv[10] = bflo(p1.y); pv[11] = bfhi(p1.y); pv[12] = bflo(p1.z); pv[13] = bfhi(p1.z); pv[14] = bflo(p1.w); pv[15] = bfhi(p1.w);
        const float sgn = (seg < 2) ? -1.f : 1.f;
        const float* c = rc + tpos * 32 + (seg & 1) * 16; const float* s = rs + tpos * 32 + (seg & 1) * 16;
#pragma unroll
        for (int e4 = 0; e4 < 4; ++e4) { const f32x4 cv = *(const f32x4*)(c + e4 * 4), sv = *(const f32x4*)(s + e4 * 4);
#pragma unroll
            for (int e = 0; e < 4; ++e) v[e4 * 4 + e] = v[e4 * 4 + e] * cv[e] + sgn * pv[e4 * 4 + e] * sv[e]; }
    }
}
DI void retkv_phase(const bf16_t* p, const bf16_t* vtl, const bf16_t* vtc, const float* rope, const float* decay  , float* kv, LAS unsigned char* L, const int tidx, unsigned* dyn) {
    const int tid = tidx, lane = tid & 63, wave = tid >> 6, l15 = lane & 15, q = lane >> 4;
    LAS bf16_t* kf = (LAS bf16_t*)L;
    LAS bf16_t* kb = kf + 64 * 136;
    LAS int* bwk = (LAS int*)(L + 140000);
    for (;;) {
        __syncthreads(); if (tid == 0) *bwk = (int)atomicAdd(dyn, 1u); __syncthreads();
        const int it = __builtin_amdgcn_readfirstlane(*bwk);
        if (it >= 8 * 4 * 18) break;
        const int b = it / 72, h = (it / 18) & 3, n = it % 18; const bool lat = n < 16;
        const int row0 = lat ? b * 2048 + n * 128 : TL + b * 256 + (n - 16) * 128;
        const float lgf = -__expf(decay[h]), lgb = -__expf(decay[4 + h]);
        {
            const int j = tid >> 2, seg = tid & 3; float v[16];
            load_rope16(p + (size_t)(row0 + j) * DIN + 1024 + h * 64, seg, lat, rope, rope + 2048 * 32, n * 128 + j, v);
            const float wf = 0.125f * __expf(lgf * (float)(127 - j)), wb = 0.125f * __expf(lgb * (float)j);
#pragma unroll
            for (int e = 0; e < 16; ++e) { kf[(seg * 16 + e) * 136 + j] = (bf16_t)(pk2(v[e] * wf, 0.f) & 0xffffu); kb[(seg * 16 + e) * 136 + j] = (bf16_t)(pk2(v[e] * wb, 0.f) & 0xffffu); }
        }
        __syncthreads();
        {
            const int dir = wave >> 2, et = wave & 3;
            const bf16_t* vsrc = lat ? vtl + ((size_t)(b * 4 + h) * 64 + et * 16 + l15) * 2048 + n * 128 : vtc + ((size_t)(b * 4 + h) * 64 + et * 16 + l15) * 256 + (n - 16) * 128;
            LAS bf16_t* ks = dir ? kb : kf;
            f32x4 acc[4];
#pragma unroll
            for (int dt = 0; dt < 4; ++dt) acc[dt] = (f32x4){0.f, 0.f, 0.f, 0.f};
#pragma unroll
            for (int kk = 0; kk < 4; ++kk) {
                const bf16x8 af = ld8(vsrc + kk * 32 + q * 8);
#pragma unroll
                for (int dt = 0; dt < 4; ++dt) { const bf16x8 bf = *(const LAS bf16x8*)(ks + (dt * 16 + l15) * 136 + kk * 32 + q * 8); acc[dt] = mfma16(af, bf, acc[dt]); }
            }
            float* dst = kv + ((size_t)((b * 4 + h) * 2 + dir) * 18 + n) * 4096;
#pragma unroll
            for (int dt = 0; dt < 4; ++dt)
#pragma unroll
                for (int jj = 0; jj < 4; ++jj) dst[(et * 16 + q * 4 + jj) * 64 + dt * 16 + l15] = acc[dt][jj];
        }
        __syncthreads();
    }
}

template <bool LOCAL>
DI void attn2_task(const bf16_t* p, const bf16_t* vtl, const bf16_t* vtc, const LAS float* rpbh  , bf16_t* y, int b, int h, int qrow0, int r, int pr, int lane) {
    constexpr int NB = LOCAL ? 12 : 4, NLB = LOCAL ? 8 : 0;
    constexpr float C1 = 0.125f * 1.44269504089f;
    const int l15 = lane & 15, q = lane >> 4, kperm = 8 * (l15 >> 2) + (l15 & 3);
    bf16x8 qf[2][2];
#pragma unroll
    for (int g = 0; g < 2; ++g) { const bf16_t* qsrc = p + (size_t)(qrow0 + g * 16 + l15) * DIN + 2048 + h * 64 + q * 8; qf[g][0] = ld8(qsrc); qf[g][1] = ld8(qsrc + 32); }
    const int rs = min(max(r - 4, 0), 24);
    unsigned inval = 0u; int boff[2];
    if (LOCAL) {
#pragma unroll
        for (int g = 0; g < 2; ++g) {
            const int qc = (2 * pr + g) * 16 + l15, qs = min(max(qc - 8, 0), 48);
            boff[g] = 63 - qc + 8 * q;
#pragma unroll
            for (int t = 0; t < 4; ++t)
#pragma unroll
                for (int jj = 0; jj < 4; ++jj) { const int kcol = (t >> 1) * 32 + 8 * q + 4 * (t & 1) + jj; if (!((kcol >= qs) && (kcol < qs + 16))) inval |= 1u << (g * 16 + t * 4 + jj); }
        }
    }
    float mrun[2] = {-3.0e38f, -3.0e38f}, sum[2] = {0.f, 0.f};
    f32x4 o[4][2];
#pragma unroll
    for (int et = 0; et < 4; ++et) { o[et][0] = (f32x4){0.f, 0.f, 0.f, 0.f}; o[et][1] = o[et][0]; }
    const bf16_t* kbase = p + 2304 + h * 64 + q * 8;
    bf16x8 kc[4][2], kn[4][2];
#define A2_LOADK(dst, blk_) do { const int kr0_ = (LOCAL && (blk_) < NLB) ? b * 2048 + (rs + (blk_)) * 64 : TL + b * 256 + ((blk_) - NLB) * 64; \
        _Pragma("unroll") for (int t = 0; t < 4; ++t) { const bf16_t* ks_ = kbase + (size_t)(kr0_ + (t >> 1) * 32 + kperm + 4 * (t & 1)) * DIN; dst[t][0] = ld8(ks_); dst[t][1] = ld8(ks_ + 32); } } while (0)
    A2_LOADK(kc, 0);
#pragma unroll
    for (int t = 0; t < 4; ++t) { kn[t][0] = kc[t][0]; kn[t][1] = kc[t][1]; }
#pragma unroll 1
    for (int blk = 0; blk < NB; ++blk) {
        const bool loc = LOCAL && blk < NLB;
        bf16x8 vf[2][4];
        {
            const bf16_t* vb = loc ? vtl + ((size_t)(b * 4 + h) * 64 + l15) * 2048 + (rs + blk) * 64 + q * 8 : vtc + ((size_t)(b * 4 + h) * 64 + l15) * 256 + (blk - NLB) * 64 + q * 8;
            const int vld = loc ? 2048 : 256;
#pragma unroll
            for (int hb = 0; hb < 2; ++hb)
#pragma unroll
                for (int et = 0; et < 4; ++et) vf[hb][et] = ld8(vb + (size_t)(et * 16) * vld + hb * 32);
        }
        if (blk + 1 < NB) A2_LOADK(kn, blk + 1);
        const LAS float* brow = rpbh + (rs + blk - r + 7) * 128;
#pragma unroll
        for (int g = 0; g < 2; ++g) {
            bool use[2]; use[0] = !loc || (g != pr) || (pr == 0); use[1] = !loc || (g != pr) || (pr == 1);
            f32x4 s[4];
            float mx = -3.0e38f;
#pragma unroll
            for (int t = 0; t < 4; ++t) {
                if (use[t >> 1]) {
                    f32x4 acc = {0.f, 0.f, 0.f, 0.f}; acc = mfma16(kc[t][0], qf[g][0], acc); acc = mfma16(kc[t][1], qf[g][1], acc);
                    if (loc) {
#pragma unroll
                        for (int jj = 0; jj < 4; ++jj) {
                            const float bias = brow[boff[g] + (t >> 1) * 32 + 4 * (t & 1) + jj];
                            const int im = __builtin_amdgcn_sbfe(inval, g * 16 + t * 4 + jj, 1);
                            acc[jj] = (acc[jj] * C1 + bias) + __int_as_float(im & (int)0xF149F2CA);
                        }
                    } else { acc = acc * C1; }
                    s[t] = acc;
                    mx = fmaxf(mx, fmaxf(fmaxf(acc[0], acc[1]), fmaxf(acc[2], acc[3])));
                } else s[t] = (f32x4){0.f, 0.f, 0.f, 0.f};
            }
            mx = fmaxf(mx, __shfl_xor(mx, 16)); mx = fmaxf(mx, __shfl_xor(mx, 32));
            const float mnew = fmaxf(mrun[g], mx), resc = __builtin_amdgcn_exp2f(mrun[g] - mnew);
            mrun[g] = mnew;
#pragma unroll
            for (int et = 0; et < 4; ++et) o[et][g] = o[et][g] * resc;
            float ps = 0.f;
#pragma unroll
            for (int t = 0; t < 4; ++t) if (use[t >> 1]) {
#pragma unroll
                for (int jj = 0; jj < 4; ++jj) { const float e = __builtin_amdgcn_exp2f(s[t][jj] - mnew); s[t][jj] = e; ps += e; }
            }
            ps += __shfl_xor(ps, 16); ps += __shfl_xor(ps, 32);
            sum[g] = sum[g] * resc + ps;
#pragma unroll
            for (int hb = 0; hb < 2; ++hb) if (use[hb]) {
                u32x4 pw; pw.x = pk2(s[2 * hb][0], s[2 * hb][1]); pw.y = pk2(s[2 * hb][2], s[2 * hb][3]); pw.z = pk2(s[2 * hb + 1][0], s[2 * hb + 1][1]); pw.w = pk2(s[2 * hb + 1][2], s[2 * hb + 1][3]);
                const bf16x8 pf = u4_as_bf8(pw);
#pragma unroll
                for (int et = 0; et < 4; ++et) o[et][g] = mfma16(vf[hb][et], pf, o[et][g]);
            }
        }
#pragma unroll
        for (int t = 0; t < 4; ++t) { kc[t][0] = kn[t][0]; kc[t][1] = kn[t][1]; }
    }
#undef A2_LOADK
#pragma unroll
    for (int g = 0; g < 2; ++g) {
        const float inv = 1.0f / sum[g];
        bf16_t* dst = y + (size_t)(qrow0 + g * 16 + l15) * DM + 768 + h * 64 + q * 4;
#pragma unroll
        for (int et = 0; et < 4; ++et) { u32x2 w; w.x = pk2(o[et][g][0] * inv, o[et][g][1] * inv); w.y = pk2(o[et][g][2] * inv, o[et][g][3] * inv); *(u32x2*)(dst + et * 16) = w; }
    }
}

DI int ret_fexp(int n, int m) { if (n < 16) { if (m < n) return n - 1 - m; if (m == 16) return n + 1; if (m == 17) return n; return -1; } if (n == 17 && m == 16) return 0; return -1; }
DI int ret_bexp(int n, int m) { if (n < 16) { if (m > n && m < 16) return m - n - 1; if (m == 16) return 15 - n; if (m == 17) return 16 - n; return -1; } if (n == 16 && m == 17) return 0; return -1; }

DI void retout_item(const bf16_t* p, const bf16_t* vtl, const bf16_t* vtc, const float* rope, const float* decay, const float* kv, bf16_t* y, LAS unsigned char* L, int b, int h, int n, const int tidx) {
    const int tid = tidx, lane = tid & 63, wave = tid >> 6, l15 = lane & 15, q = lane >> 4;
    LAS bf16_t* Qs = (LAS bf16_t*)L;
    LAS bf16_t* Ks = Qs + 128 * 72;
    LAS bf16_t* Sf = Ks + 128 * 72;
    LAS bf16_t* Sb = Sf + 64 * 72;
    const bool lat = n < 16;
    const int row0 = lat ? b * 2048 + n * 128 : TL + b * 256 + (n - 16) * 128;
    const float lgf = -__expf(decay[h]), lgb = -__expf(decay[4 + h]);
    {
        const int idx = tid * 8, e = idx >> 6, d0 = idx & 63;
        f32x4 f0 = {0.f, 0.f, 0.f, 0.f}, f1 = f0, b0 = f0, b1 = f0;
        const float* kvf = kv + ((size_t)((b * 4 + h) * 2 + 0) * 18) * 4096 + idx;
        const float* kvb = kv + ((size_t)((b * 4 + h) * 2 + 1) * 18) * 4096 + idx;
        const float gf = __expf(lgf * 128.0f), gb = __expf(lgb * 128.0f);
        if (lat) {
            float w = 1.0f;
#pragma unroll 4
            for (int m = n - 1; m >= 0; --m) { f0 += w * *(const f32x4*)(kvf + (size_t)m * 4096); f1 += w * *(const f32x4*)(kvf + (size_t)m * 4096 + 4); w *= gf; }
            f0 += w * (gf * *(const f32x4*)(kvf + (size_t)16 * 4096) + *(const f32x4*)(kvf + (size_t)17 * 4096));
            f1 += w * (gf * *(const f32x4*)(kvf + (size_t)16 * 4096 + 4) + *(const f32x4*)(kvf + (size_t)17 * 4096 + 4));
            w = 1.0f;
#pragma unroll 4
            for (int m = n + 1; m < 16; ++m) { b0 += w * *(const f32x4*)(kvb + (size_t)m * 4096); b1 += w * *(const f32x4*)(kvb + (size_t)m * 4096 + 4); w *= gb; }
            b0 += w * (*(const f32x4*)(kvb + (size_t)16 * 4096) + gb * *(const f32x4*)(kvb + (size_t)17 * 4096));
            b1 += w * (*(const f32x4*)(kvb + (size_t)16 * 4096 + 4) + gb * *(const f32x4*)(kvb + (size_t)17 * 4096 + 4));
        } else if (n == 16) { b0 = *(const f32x4*)(kvb + (size_t)17 * 4096); b1 = *(const f32x4*)(kvb + (size_t)17 * 4096 + 4); }
        else { f0 = *(const f32x4*)(kvf + (size_t)16 * 4096); f1 = *(const f32x4*)(kvf + (size_t)16 * 4096 + 4); }
        u32x4 w; w.x = pk2(f0[0], f0[1]); w.y = pk2(f0[2], f0[3]); w.z = pk2(f1[0], f1[1]); w.w = pk2(f1[2], f1[3]);
        *(LAS u32x4*)(Sf + e * 72 + d0) = w;
        w.x = pk2(b0[0], b0[1]); w.y = pk2(b0[2], b0[3]); w.z = pk2(b1[0], b1[1]); w.w = pk2(b1[2], b1[3]);
        *(LAS u32x4*)(Sb + e * 72 + d0) = w;
    }
    {
        const int j = tid >> 2, seg = tid & 3; float v[16];
        load_rope16(p + (size_t)(row0 + j) * DIN + 768 + h * 64, seg, lat, rope, rope + 2048 * 32, n * 128 + j, v);
        u32x4 w; w.x = pk2(v[0], v[1]); w.y = pk2(v[2], v[3]); w.z = pk2(v[4], v[5]); w.w = pk2(v[6], v[7]);
        *(LAS u32x4*)(Qs + j * 72 + seg * 16) = w;
        w.x = pk2(v[8], v[9]); w.y = pk2(v[10], v[11]); w.z = pk2(v[12], v[13]); w.w = pk2(v[14], v[15]);
        *(LAS u32x4*)(Qs + j * 72 + seg * 16 + 8) = w;
        load_rope16(p + (size_t)(row0 + j) * DIN + 1024 + h * 64, seg, lat, rope, rope + 2048 * 32, n * 128 + j, v);
        w.x = pk2(v[0] * 0.125f, v[1] * 0.125f); w.y = pk2(v[2] * 0.125f, v[3] * 0.125f); w.z = pk2(v[4] * 0.125f, v[5] * 0.125f); w.w = pk2(v[6] * 0.125f, v[7] * 0.125f);
        *(LAS u32x4*)(Ks + j * 72 + seg * 16) = w;
        w.x = pk2(v[8] * 0.125f, v[9] * 0.125f); w.y = pk2(v[10] * 0.125f, v[11] * 0.125f); w.z = pk2(v[12] * 0.125f, v[13] * 0.125f); w.w = pk2(v[14] * 0.125f, v[15] * 0.125f);
        *(LAS u32x4*)(Ks + j * 72 + seg * 16 + 8) = w;
    }
    __syncthreads();
    {
        const int il = wave * 16 + l15;
        const bf16x8 qf0 = *(const LAS bf16x8*)(Qs + il * 72 + q * 8), qf1 = *(const LAS bf16x8*)(Qs + il * 72 + 32 + q * 8);
        f32x4 o[4];
#pragma unroll
        for (int et = 0; et < 4; ++et) o[et] = (f32x4){0.f, 0.f, 0.f, 0.f};
        const bf16_t* vbase = lat ? vtl + ((size_t)(b * 4 + h) * 64 + l15) * 2048 + n * 128 : vtc + ((size_t)(b * 4 + h) * 64 + l15) * 256 + (n - 16) * 128;
        const int vld = lat ? 2048 : 256;
#pragma unroll
        for (int u = 0; u < 4; ++u) {
            f32x4 st[2];
#pragma unroll
            for (int x = 0; x < 2; ++x) {
                const int jr = u * 32 + 8 * (l15 >> 2) + 4 * x + (l15 & 3);
                const bf16x8 k0 = *(const LAS bf16x8*)(Ks + jr * 72 + q * 8), k1 = *(const LAS bf16x8*)(Ks + jr * 72 + 32 + q * 8);
                f32x4 acc = {0.f, 0.f, 0.f, 0.f};
                acc = mfma16(k0, qf0, acc); acc = mfma16(k1, qf1, acc);
#pragma unroll
                for (int jj = 0; jj < 4; ++jj) { const int j = u * 32 + 8 * q + 4 * x + jj; const int dd = il - j;
                    const float dm = dd > 0 ? __expf(lgf * (float)dd) : (dd < 0 ? __expf(lgb * (float)(-dd)) : 2.0f); acc[jj] *= dm; }
                st[x] = acc;
            }
            u32x4 pw; pw.x = pk2(st[0][0], st[0][1]); pw.y = pk2(st[0][2], st[0][3]); pw.z = pk2(st[1][0], st[1][1]); pw.w = pk2(st[1][2], st[1][3]);
            const bf16x8 pf = u4_as_bf8(pw);
#pragma unroll
            for (int et = 0; et < 4; ++et) { const bf16x8 vf = ld8(vbase + (size_t)(et * 16) * vld + u * 32 + q * 8); o[et] = mfma16(vf, pf, o[et]); }
        }
        const float rf = __expf(lgf * (float)(il + 1)), rb = __expf(lgb * (float)(128 - il));
#pragma unroll
        for (int et = 0; et < 4; ++et) {
            f32x4 af = {0.f, 0.f, 0.f, 0.f}, ab = af;
            af = mfma16(*(const LAS bf16x8*)(Sf + (et * 16 + l15) * 72 + q * 8), qf0, af); af = mfma16(*(const LAS bf16x8*)(Sf + (et * 16 + l15) * 72 + 32 + q * 8), qf1, af);
            ab = mfma16(*(const LAS bf16x8*)(Sb + (et * 16 + l15) * 72 + q * 8), qf0, ab); ab = mfma16(*(const LAS bf16x8*)(Sb + (et * 16 + l15) * 72 + 32 + q * 8), qf1, ab);
            o[et] = o[et] + rf * af + rb * ab;
        }
        float sm = 0.f;
#pragma unroll
        for (int et = 0; et < 4; ++et) sm += (o[et][0] + o[et][1]) + (o[et][2] + o[et][3]);
        sm += __shfl_xor(sm, 16); sm += __shfl_xor(sm, 32);
        const float mu = sm * (1.0f / 64.0f); float vs = 0.f;
#pragma unroll
        for (int et = 0; et < 4; ++et) { o[et] = o[et] - mu; vs += (o[et][0] * o[et][0] + o[et][1] * o[et][1]) + (o[et][2] * o[et][2] + o[et][3] * o[et][3]); }
        vs += __shfl_xor(vs, 16); vs += __shfl_xor(vs, 32);
        const float rstd = rsqrtf(vs * (1.0f / 64.0f) + EPSV);
        const bf16_t* gsrc = p + (size_t)(row0 + il) * DIN + 1536 + h * 64 + q * 4;
        bf16_t* dst = y + (size_t)(row0 + il) * DM + 256 + h * 64 + q * 4;
#pragma unroll
        for (int et = 0; et < 4; ++et) { const u32x2 gw = *(const u32x2*)(gsrc + et * 16);
            u32x2 w; w.x = pk2(silu_f(bflo(gw.x)) * o[et][0] * rstd, silu_f(bfhi(gw.x)) * o[et][1] * rstd); w.y = pk2(silu_f(bflo(gw.y)) * o[et][2] * rstd, silu_f(bfhi(gw.y)) * o[et][3] * rstd);
            *(u32x2*)(dst + et * 16) = w; }
    }
}

DI void ffn_fixup_phase(const float* uB, const float* cw, bf16_t* G, int nblk, const int tidx) {
    const int gt = blockIdx.x * NTHREADS + tidx, ngt = gridDim.x * NTHREADS;
    for (int idx = gt; idx < nblk * 2 * (DFF / 4); idx += ngt) {
        const int c4 = (idx % (DFF / 4)) * 4, rb = idx / (DFF / 4), blk = rb >> 1, last = rb & 1;
        bool sstart, send;
        if (blk < 256) { sstart = (blk & 31) == 0; send = (blk & 31) == 31; } else { sstart = ((blk - 256) & 3) == 0; send = ((blk - 256) & 3) == 3; }
        const float* prev; const float* cur; const float* next; bool hp = true, hn = true;
        if (!last) { cur = uB + ((size_t)blk * 4 + 0) * NUP; next = uB + ((size_t)blk * 4 + 1) * NUP; prev = uB + ((size_t)(blk - 1) * 4 + 3) * NUP; hp = !sstart; if (sstart) prev = cur; }
        else { cur = uB + ((size_t)blk * 4 + 3) * NUP; prev = uB + ((size_t)blk * 4 + 2) * NUP; next = uB + ((size_t)(blk + 1) * 4 + 0) * NUP; hn = !send; if (send) next = cur; }
        f32x4 ca = *(const f32x4*)(cw + NUP + c4) * *(const f32x4*)(cur + c4), cb = *(const f32x4*)(cw + NUP + DFF + c4) * *(const f32x4*)(cur + DFF + c4);
        if (hp) { ca += *(const f32x4*)(cw + c4) * *(const f32x4*)(prev + c4); cb += *(const f32x4*)(cw + DFF + c4) * *(const f32x4*)(prev + DFF + c4); }
        if (hn) { ca += *(const f32x4*)(cw + 2 * NUP + c4) * *(const f32x4*)(next + c4); cb += *(const f32x4*)(cw + 2 * NUP + DFF + c4) * *(const f32x4*)(next + DFF + c4); }
        u32x2 w; w.x = pk2(silu_f(ca[0]) * cb[0], silu_f(ca[1]) * cb[1]); w.y = pk2(silu_f(ca[2]) * cb[2], silu_f(ca[3]) * cb[3]);
        *(u32x2*)(G + (size_t)(blk * 64 + (last ? 63 : 0)) * DFF + c4) = w;
    }
}

#define GSYNC() do { XcdBarrier xb_; xb_.bar = (unsigned*)(((const __attribute__((address_space(4))) Args*)__builtin_amdgcn_kernarg_segment_ptr())->ws + WS_BAR); xb_.x = xb_xcc_id(); xb_.st = (volatile LAS unsigned*)(L + 140032); xcd_barrier(xb_); } while (0)
#define FRESH() int tid = threadIdx.x; asm volatile("" : "+v"(tid)); const __attribute__((address_space(4))) Args* ap_ = (const __attribute__((address_space(4))) Args*)__builtin_amdgcn_kernarg_segment_ptr(); asm volatile("" : "+s"(ap_)); const __attribute__((address_space(4))) Args& a = *ap_; unsigned char* ws = a.ws; asm volatile("" : "+s"(ws)); const int lane = tid & 63, wave = __builtin_amdgcn_readfirstlane(tid >> 6), gw = bx * 8 + wave; (void)lane; (void)wave; (void)gw; (void)ws
__global__ void __launch_bounds__(NTHREADS) mk_fwd(Args a_k) {
    extern __shared__ __attribute__((aligned(16))) unsigned char lds_raw[];
    LAS unsigned char* L = (LAS unsigned char*)lds_raw;
    cg::grid_group grid = cg::this_grid();
    const int G = gridDim.x, bx = blockIdx.x, ngw = G * 8;
    volatile LAS unsigned* xst = (volatile LAS unsigned*)(L + 140032);
    if (threadIdx.x < 2) xst[threadIdx.x] = 0u;
    __syncthreads();
    (void)xcd_barrier_post((unsigned*)(a_k.ws + WS_BAR), xst);

    {
        FRESH();
        if (PHON(0)) { mods_phase(a, L, (float*)(ws + WS_MOD), tid); tables_phase(ws, tid); }
        if (PHON(1)) {
            convert_weight(a.in[I_WIN], DM, DIN, (bf16_t*)(ws + WS_WIN), L, gw, ngw, lane, wave);
        }
    }
    { asm volatile("s_waitcnt vmcnt(0) lgkmcnt(0)" ::: "memory"); __syncthreads();
      if (threadIdx.x == 0) { __builtin_amdgcn_fence(__ATOMIC_RELEASE, "agent"); asm volatile("s_waitcnt vmcnt(0)" ::: "memory"); }
      grid.sync();
      if (threadIdx.x == 0) { __builtin_amdgcn_fence(__ATOMIC_ACQUIRE, "agent"); asm volatile("s_waitcnt vmcnt(0)" ::: "memory"); }
      __syncthreads(); }
    {
        FRESH();
        const float* mods = (const float*)(ws + WS_MOD);
        if (PHON(2)) rowwise_phase<false, false>(a.in[I_X], a.in[I_CTX], nullptr, nullptr, nullptr, nullptr, nullptr, a.in[I_GPREMIX], mods + 1 * 1024, mods + 0 * 1024, (bf16_t*)(ws + WS_H), TT, tid);
    }
    GSYNC();

#pragma unroll 1
    for (int l = 0; l < DEPTH; ++l) {
        const bool with_ctx = l < DEPTH - 1;
        const int Mrows = with_ctx ? TT : TL;
        if (PHON(3)) {
            FRESH();
            pg8::Gemm g{(const bf16_t*)(ws + WS_H), WSET(l) + WOFF_IN, DM, (size_t)128 * DM * 2, (size_t)128 * DM * 2, (size_t)256 * DM * 2, (size_t)256 * DM * 2};
            pg8::StaticOrder S; if (with_ctx) S.init(TT, DIN, G, bx, 16, 0, 1); else S.init(TL, DIN, G, bx, 16, 32, 1);
            pg8::EpiP E{(bf16_t*)(ws + WS_A + A_P), (bf16_t*)(ws + WS_A + A_VTRL), (bf16_t*)(ws + WS_A + A_VTRC), (bf16_t*)(ws + WS_A + A_VTNL), (bf16_t*)(ws + WS_A + A_VTNC)};
            pg8::gemm_phase<pg8::EpiP, pg8::StaticOrder, true, true>(L, g, S, E, tid);
        }
        if (PHON(1)) {
            FRESH();
            const bool nx = l + 1 < DEPTH; bf16_t* w0 = WSET(0); bf16_t* w1 = WSET(l + 1);
            const ConvJob jobs[5] = { {l == 0 ? a.in[I_WOUT] : nullptr, w0 + WOFF_OUT, DM, DM}, {l == 0 ? a.in[I_WUP] : nullptr, w0 + WOFF_UP, DM, NUP}, {l == 0 ? a.in[I_WDOWN] : nullptr, w0 + WOFF_DN, DFF, DM},
                {nx ? a.in[I_WIN] + (size_t)(l + 1) * DM * DIN : nullptr, w1 + WOFF_IN, DM, DIN}, {nx ? a.in[I_WOUT] + (size_t)(l + 1) * DM * DM : nullptr, w1 + WOFF_OUT, DM, DM} };
            filler_convert<5>(jobs, (unsigned*)(ws + WS_CTL) + 32 + l, L, tid, lane, wave);
        }
        GSYNC();
        {
            FRESH();
            const bf16_t* pbuf = (const bf16_t*)(ws + WS_A + A_P);
            if (PHON(4)) chdft_phase(pbuf, (const bf16_t*)(ws + WS_CMAT), (bf16_t*)(ws + WS_B + B_ZT), (bf16_t*)(ws + WS_B + B_ZCT), with_ctx, gw, ngw, lane);
            if (PHON(6)) retkv_phase(pbuf, (const bf16_t*)(ws + WS_A + A_VTRL), (const bf16_t*)(ws + WS_A + A_VTRC), (const float*)(ws + WS_ROPE), a.in[I_RETDECAY] + l * 8, (float*)(ws + WS_B + B_KV), L, tid, (unsigned*)(ws + WS_CTL) + 56 + l);
        }
        GSYNC();
        {
            if (PHON(7) && PHON(18)) {
                FRESH();
                pg8::Gemm g{(const bf16_t*)(ws + WS_DFT), (const bf16_t*)(ws + WS_B + B_ZT), 2048, (size_t)128 * 2048 * 2, (size_t)128 * 2048 * 2, (size_t)256 * 2048 * 2, (size_t)256 * 2048 * 2};
                pg8::FourierOrder S{bx, 1};
                pg8::EpiBf16S E{(bf16_t*)(ws + WS_A + A_Y) + 512, DM, 0.00276213586f  };
                pg8::gemm_phase<pg8::EpiBf16S, pg8::FourierOrder, false, true>(L, g, S, E, tid);
            }
            if (PHON(7) && PHON(17) && with_ctx) {
                FRESH();
                pg8::Gemm g{(const bf16_t*)(ws + WS_DFTC), (const bf16_t*)(ws + WS_B + B_ZCT), 512, (size_t)128 * 512 * 2, (size_t)128 * 512 * 2, (size_t)256 * 512 * 2, (size_t)256 * 512 * 2};
                pg8::FourierOrder S{bx, 0};
                pg8::EpiBf16S E{(bf16_t*)(ws + WS_A + A_Y) + 512, DM, 0.0078125f  };
                pg8::gemm_phase<pg8::EpiBf16S, pg8::FourierOrder, false, true>(L, g, S, E, tid);
            }
            const int n_nat = 256, n_ret = with_ctx ? 576 : 512, n_cc = with_ctx ? 32 : 0, n_sc = Mrows / 64, n_items = n_nat + n_ret + n_cc + n_sc;
            for (;;) {
                FRESH();
                LAS int* bw = (LAS int*)(L + 140000);
                __syncthreads();
                if (tid == 0) *bw = (int)atomicAdd((unsigned*)(ws + WS_CTL) + 16 + l, 1u);
                __syncthreads();
                const int it = __builtin_amdgcn_readfirstlane(*bw);
                if (it >= n_items) break;
                const bf16_t* pbuf = (const bf16_t*)(ws + WS_A + A_P); bf16_t* ybuf = (bf16_t*)(ws + WS_A + A_Y);
                const float* rpb = a.in[I_RPB] + (size_t)l * 4 * 15 * 31;
                if (PHON(8) && it < n_nat) {
                    const int b = it >> 5, r = it & 31;
                    LAS float* rl = (LAS float*)L;
                    for (int i = tid; i < 4 * 15 * 128; i += NTHREADS) { const int d = (i & 127) - 63, hr = i >> 7; rl[i] = (d >= -15 && d <= 15) ? rpb[hr * 31 + d + 15] * 1.44269504089f : 0.f; }
                    __syncthreads();
                    { const int h = wave >> 1, pr = wave & 1;
                      attn2_task<true>(pbuf, (const bf16_t*)(ws + WS_A + A_VTNL), (const bf16_t*)(ws + WS_A + A_VTNC), rl + h * 1920, ybuf, b, h, b * 2048 + r * 64 + pr * 32, r, pr, lane); }
                } else if (PHON(9) && it >= n_nat && it < n_nat + n_ret) {
                    const int k = it - n_nat; int b, h, n;
                    if (with_ctx) { b = k / 72; h = (k / 18) & 3; n = k % 18; } else { b = k >> 6; h = (k >> 4) & 3; n = k & 15; }
                    retout_item(pbuf, (const bf16_t*)(ws + WS_A + A_VTRL), (const bf16_t*)(ws + WS_A + A_VTRC), (const float*)(ws + WS_ROPE), a.in[I_RETDECAY] + l * 8, (const float*)(ws + WS_B + B_KV), ybuf, L, b, h, n, tid);
                } else if (PHON(10) && it >= n_nat + n_ret && it < n_nat + n_ret + n_cc) {
                    const int k = it - n_nat - n_ret, b = k >> 2, h = k & 3;
                    attn2_task<false>(pbuf, (const bf16_t*)(ws + WS_A + A_VTNL), (const bf16_t*)(ws + WS_A + A_VTNC), (const LAS float*)L, ybuf, b, h, TL + b * 256 + wave * 32, 0, 0, lane);
                } else if (PHON(5) && it >= n_nat + n_ret + n_cc) {
                    sconv_item(pbuf, a.in[I_CONVW] + l * 768, ybuf, (it - n_nat - n_ret - n_cc) * 64, tid);
                }
            }
        }
        GSYNC();
        if (PHON(11)) {
            FRESH();
            pg8::Gemm g{(const bf16_t*)(ws + WS_A + A_Y), WSET(l) + WOFF_OUT, DM, (size_t)128 * DM * 2, (size_t)128 * DM * 2, (size_t)256 * DM * 2, (size_t)256 * DM * 2};
            pg8::SplitOrder S; S.init(G, bx, with_ctx ? 1 : 0, 16);
            pg8::EpiF32 E{(bf16_t*)(ws + WS_B + B_O1), DM, 16};
            pg8::gemm_phase<pg8::EpiF32, pg8::SplitOrder, true, true>(L, g, S, E, tid);
        }
        GSYNC();
        {
            FRESH();
            const float* modl = (const float*)(ws + WS_MOD) + (size_t)l * 9 * 6144;
            if (PHON(12) && l == 0) rowwise_phase<false, true>(a.in[I_X], a.in[I_CTX], nullptr, (bf16_t*)(ws + WS_XB), (const bf16_t*)(ws + WS_B + B_O1), a.in[I_GPOSTMIX] + l * DM, modl + 2 * 1024, a.in[I_GPREFFN] + l * DM, modl + 4 * 1024, modl + 3 * 1024, (bf16_t*)(ws + WS_H), Mrows, tid);
            if (PHON(12) && l != 0) rowwise_phase<true, true>(nullptr, nullptr, nullptr, (bf16_t*)(ws + WS_XB), (const bf16_t*)(ws + WS_B + B_O1), a.in[I_GPOSTMIX] + l * DM, modl + 2 * 1024, a.in[I_GPREFFN] + l * DM, modl + 4 * 1024, modl + 3 * 1024, (bf16_t*)(ws + WS_H), Mrows, tid);
        }
        GSYNC();
        if (PHON(13)) {
            FRESH();
            pg8::Gemm g{(const bf16_t*)(ws + WS_H), WSET(l) + WOFF_UP, DM, (size_t)128 * DM * 2, (size_t)DFF * DM * 2, (size_t)256 * DM * 2, (size_t)128 * DM * 2};
            pg8::StaticOrder S; S.init(Mrows, NUP, G, bx, 16);
            pg8::EpiUp E{(bf16_t*)(ws + WS_B + B_G), (float*)(ws + WS_A + A_UB), a.in[I_FFNCONVW] + (size_t)l * 3 * NUP};
            pg8::gemm_phase<pg8::EpiUp, pg8::StaticOrder, true, true>(L, g, S, E, tid);
        }
        if (PHON(1) && l + 1 < DEPTH) {
            FRESH();
            bf16_t* w1 = WSET(l + 1);
            const ConvJob jobs[2] = { {a.in[I_WUP] + (size_t)(l + 1) * DM * NUP, w1 + WOFF_UP, DM, NUP}, {a.in[I_WDOWN] + (size_t)(l + 1) * DFF * DM, w1 + WOFF_DN, DFF, DM} };
            filler_convert<2>(jobs, (unsigned*)(ws + WS_CTL) + 40 + l, L, tid, lane, wave);
        }
        GSYNC();
        {
            FRESH();
            if (PHON(14)) ffn_fixup_phase((const float*)(ws + WS_A + A_UB), a.in[I_FFNCONVW] + (size_t)l * 3 * NUP, (bf16_t*)(ws + WS_B + B_G), Mrows / 64, tid);
        }
        GSYNC();
        if (PHON(15)) {
            FRESH();
            pg8::Gemm g{(const bf16_t*)(ws + WS_B + B_G), WSET(l) + WOFF_DN, DFF, (size_t)128 * DFF * 2, (size_t)128 * DFF * 2, (size_t)256 * DFF * 2, (size_t)256 * DFF * 2};
            pg8::SplitOrder S; S.init(G, bx, with_ctx ? 1 : 0, 44);
            pg8::EpiF32 E{(bf16_t*)(ws + WS_A + A_O2), DM, 44};
            pg8::gemm_phase<pg8::EpiF32, pg8::SplitOrder, true, true>(L, g, S, E, tid);
        }
        GSYNC();
        {
            FRESH();
            const float* modl = (const float*)(ws + WS_MOD) + (size_t)l * 9 * 6144;
            if (!PHON(16)) {} else if (l + 1 < DEPTH) {
                const float* modn = modl + 9 * 6144;
                rowwise_phase<true, true>(nullptr, nullptr, nullptr, (bf16_t*)(ws + WS_XB), (const bf16_t*)(ws + WS_A + A_O2), a.in[I_GPOSTFFN] + l * DM, modl + 5 * 1024, a.in[I_GPREMIX] + (l + 1) * DM, modn + 1 * 1024, modn + 0 * 1024, (bf16_t*)(ws + WS_H), Mrows, tid);
            } else {
                rowwise_phase<true, false>(nullptr, nullptr, a.out, (bf16_t*)(ws + WS_XB), (const bf16_t*)(ws + WS_A + A_O2), a.in[I_GPOSTFFN] + l * DM, modl + 5 * 1024, nullptr, nullptr, nullptr, nullptr, Mrows, tid);
            }
        }
        if (l + 1 < DEPTH) GSYNC();
    }
}

extern "C" void kernel_launch(void* const* d_in, const int* in_sizes, int n_in, void* d_out, int out_size, void* d_ws, size_t ws_size, hipStream_t stream) {
    static int grid_blocks = 0;
    if (grid_blocks == 0) {
        if (n_in != 18 || ws_size < WS_END) { fprintf(stderr, "kernel_launch: bad sizes n_in %d ws %zu need %zu\n", n_in, ws_size, (size_t)WS_END); grid_blocks = -1; return; }
        int dev = 0, cus = 0, per_cu = 0;
        hipGetDevice(&dev);
        hipDeviceGetAttribute(&cus, hipDeviceAttributeMultiprocessorCount, dev);
        if (hipFuncSetAttribute((const void*)mk_fwd, hipFuncAttributeMaxDynamicSharedMemorySize, LDS_BYTES) != hipSuccess) { fprintf(stderr, "kernel_launch: hipFuncSetAttribute failed\n"); grid_blocks = -1; return; }
        if (hipOccupancyMaxActiveBlocksPerMultiprocessor(&per_cu, (const void*)mk_fwd, NTHREADS, LDS_BYTES) != hipSuccess || per_cu < 1) { fprintf(stderr, "kernel_launch: occupancy query failed (%d)\n", per_cu); (void)hipGetLastError(); per_cu = 1; }
        grid_blocks = cus * 1;
        fprintf(stderr, "kernel_launch: cus %d per_cu %d grid %d ws %zu need %zu\n", cus, per_cu, grid_blocks, ws_size, (size_t)WS_END);
    }
    if (grid_blocks < 0) return;
    (void)hipMemsetAsync((char*)d_ws + WS_CTL, 0, 32768, stream);
    Args a{};
    for (int i = 0; i < 18; ++i) a.in[i] = (const float*)d_in[i];
    a.out = (float*)d_out; a.ws = (unsigned char*)d_ws;
    void* args[] = {&a};
    hipError_t e = hipLaunchCooperativeKernel((const void*)mk_fwd, dim3(grid_blocks), dim3(NTHREADS), args, LDS_BYTES, stream);
    if (e != hipSuccess) fprintf(stderr, "cooperative launch failed: %s (grid %d)\n", hipGetErrorString(e), grid_blocks);
}
```

```cpp
#include <hip/hip_runtime.h>
#include <hip/hip_cooperative_groups.h>
#include <cstdio>
#include <cstdint>
namespace cg = cooperative_groups;

#define LAS __attribute__((address_space(3)))
#define DI __device__ __forceinline__
typedef unsigned short bf16_t;
typedef short bf16x8 __attribute__((ext_vector_type(8)));
typedef short bf16x4 __attribute__((ext_vector_type(4)));
typedef float f32x4 __attribute__((ext_vector_type(4)));
typedef unsigned u32x4 __attribute__((ext_vector_type(4)));
typedef unsigned u32x2 __attribute__((ext_vector_type(2)));

constexpr int DM = 1024, NBATCH = 8, SEQ = 2048, CTXL = 256, DEPTH = 4, DIN = 2816, DFF = 2816, NUP = 5632;
constexpr int TL = NBATCH * SEQ, TC = NBATCH * CTXL, TT = TL + TC;
constexpr int NTHREADS = 512;
constexpr int LDS_BYTES = 147456;
constexpr float EPSV = 1e-6f;

constexpr size_t al256(size_t x) { return (x + 255) & ~(size_t)255; }
constexpr size_t WS_CTL = 0;
constexpr size_t WS_BAR = 4096;
constexpr size_t WS_MOD = 32768;
constexpr size_t WS_ROPE = al256(WS_MOD + (size_t)4 * 9 * 6144 * 4);
constexpr size_t WS_CMAT = al256(WS_ROPE + (size_t)2 * 2048 * 32 * 4);
constexpr size_t WS_DFT = al256(WS_CMAT + 128 * 64 * 2);
constexpr size_t WS_DFTC = al256(WS_DFT + (size_t)2048 * 4096 * 2);
constexpr size_t WS_CTX = al256(WS_DFTC + (size_t)256 * 512 * 2);
constexpr size_t WS_H = al256(WS_CTX + (size_t)TC * DM * 4);
constexpr size_t WS_WIN = al256(WS_H + (size_t)TT * DM * 2);
constexpr size_t WS_WOUT = al256(WS_WIN + (size_t)DIN * DM * 2);
constexpr size_t WS_WUP = al256(WS_WOUT + (size_t)DM * DM * 2);
constexpr size_t WS_WDN = al256(WS_WUP + (size_t)NUP * DM * 2);
constexpr size_t WS_A = al256(WS_WDN + (size_t)DM * DFF * 2);
constexpr size_t A_P = 0;
constexpr size_t A_Y = al256(A_P + (size_t)TT * DIN * 2);
constexpr size_t A_VTRL = al256(A_Y + (size_t)TT * DM * 2);
constexpr size_t A_VTRC = al256(A_VTRL + (size_t)32 * 64 * 2048 * 2);
constexpr size_t A_VTNL = al256(A_VTRC + (size_t)32 * 64 * 256 * 2);
constexpr size_t A_VTNC = al256(A_VTNL + (size_t)32 * 64 * 2048 * 2);
constexpr size_t A_END = al256(A_VTNC + (size_t)32 * 64 * 256 * 2);
constexpr size_t A_UB = 0;
constexpr size_t A_O2 = al256((size_t)288 * 4 * 5632 * 4);
static_assert(A_O2 + (size_t)(TL + 4 * TC) * DM * 4 <= A_END, "A region");
constexpr size_t WS_B = al256(WS_A + A_END);
constexpr size_t B_ZT = 0;
constexpr size_t B_ZCT = al256(B_ZT + (size_t)8 * 256 * 4096 * 2);
constexpr size_t B_KV = al256(B_ZCT + (size_t)8 * 256 * 512 * 2);
constexpr size_t B_O1 = 0;
constexpr size_t B_G = 0;
constexpr size_t B_END = al256((size_t)TT * DIN * 2);
static_assert(B_KV + (size_t)8 * 4 * 2 * 18 * 4096 * 4 <= B_END, "B region");
static_assert(B_O1 + (size_t)(TL + 4 * TC) * DM * 4 <= B_END, "B region o1");
constexpr size_t WS_XB = WS_B + B_END;
constexpr size_t WS_END = al256(WS_XB + (size_t)TT * DM * 2);

typedef __bf16 bf2_t __attribute__((ext_vector_type(2)));
typedef float f32x2_t __attribute__((ext_vector_type(2)));
DI unsigned pk2(float lo, float hi) { f32x2_t f = {lo, hi}; bf2_t v = __builtin_convertvector(f, bf2_t); return __builtin_bit_cast(unsigned, v); }
DI unsigned pk2v(float lo, float hi) { return pk2(lo, hi); }
typedef _Float16 h2_t __attribute__((ext_vector_type(2)));
DI unsigned pkh2(float lo, float hi) { h2_t v = {(_Float16)lo, (_Float16)hi}; return __builtin_bit_cast(unsigned, v); }
DI float hlo(unsigned w) { return (float)__builtin_bit_cast(h2_t, w)[0]; }
DI float hhi(unsigned w) { return (float)__builtin_bit_cast(h2_t, w)[1]; }
DI float bflo(unsigned w) { return __uint_as_float(w << 16); }
DI float bfhi(unsigned w) { return __uint_as_float(w & 0xffff0000u); }
DI float wave_sum(float v) {
#pragma unroll
    for (int o = 1; o < 64; o <<= 1) v += __shfl_xor(v, o);
    return v;
}
DI float silu_f(float v) { return v * __builtin_amdgcn_rcpf(1.0f + __builtin_amdgcn_exp2f(-1.44269504089f * v)); }
DI f32x4 mfma16(bf16x8 a, bf16x8 b, f32x4 c) { return __builtin_amdgcn_mfma_f32_16x16x32_bf16(a, b, c, 0, 0, 0); }
DI bf16x8 ld8(const bf16_t* p) { return *(const bf16x8*)p; }
DI bf16x8 cat4(bf16x4 a, bf16x4 b) { bf16x8 r; r[0] = a[0]; r[1] = a[1]; r[2] = a[2]; r[3] = a[3]; r[4] = b[0]; r[5] = b[1]; r[6] = b[2]; r[7] = b[3]; return r; }
DI bf16x8 u4_as_bf8(u32x4 v) { return __builtin_bit_cast(bf16x8, v); }
DI float dpp_ror1(float v) { return __int_as_float(__builtin_amdgcn_update_dpp(0, __float_as_int(v), 0x121, 0xF, 0xF, false)); }
DI float dpp_ror15(float v) { return __int_as_float(__builtin_amdgcn_update_dpp(0, __float_as_int(v), 0x12F, 0xF, 0xF, false)); }

namespace pg8 {
constexpr int BM = 256, BK = 64, HALF = 128, HTB = HALF * BK * 2, STAGE_BYTES = 8 * HTB, NXCD = 8, WGM = 8;
__host__ __device__ __forceinline__ int lds_byte(int r, int c) { const int st = (r >> 4) * 2 + (c >> 5), rr = r & 15, cc = c & 31, ob = rr * 64 + cc * 2; return st * 1024 + (ob ^ (((ob >> 9) & 1) << 5)); }
__host__ __device__ __forceinline__ void stage_rc(int b, int& R, int& C) { const int st = b / 1024, sb = b % 1024, swz = sb ^ (((sb >> 9) & 1) << 5); R = (st >> 1) * 16 + swz / 64; C = (st & 1) * 32 + (swz % 64) / 2; }
__host__ __device__ __forceinline__ int perm32(int rho) { const int n = rho >> 4, i = rho & 15; return 8 * (i >> 2) + 4 * n + (i & 3); }

struct Unit { int pm, pn, ta, tb, k0, nt, ks, sw; };
struct Gemm { const bf16_t* A; const bf16_t* Bt; int K; size_t hstepA, hstepB, tstepA, tstepB; };

struct StaticOrder {
    int nM, nN, nwg, G, c, ntk, extra, swapv;
    __device__ __forceinline__ void init(int M, int N, int G_, int c_, int ntk_, int extra_ = 0, int swapv_ = 0) { nM = M / BM; nN = N / BM; nwg = nM * nN; G = G_; c = c_; ntk = ntk_; extra = extra_; swapv = swapv_; }
    __device__ __forceinline__ bool next(int i, Unit& u) const {
        const long L = (long)i * G + c; if (L >= nwg + extra) return false;
        if (L >= nwg) { const int j = (int)L - nwg, s4 = j & 3; u.pm = 64 + (j >> 2); u.pn = s4 == 0 ? 4 : (s4 == 1 ? 5 : (s4 == 2 ? 9 : 10)); u.ta = u.pm; u.tb = u.pn; u.k0 = 0; u.nt = ntk; u.ks = 0; u.sw = swapv && (s4 & 1); return true; }
        int wgid = (int)L; { const int q = nwg / NXCD, r = nwg % NXCD, xcd = wgid % NXCD, off = wgid / NXCD; wgid = (xcd < r ? xcd * (q + 1) : r * (q + 1) + (xcd - r) * q) + off; }
        const int nig = WGM * nN, gid = wgid / nig, fm = gid * WGM, gsz = (nM - fm) < WGM ? (nM - fm) : WGM;
        u.pm = fm + ((wgid % nig) % gsz); u.pn = (wgid % nig) / gsz; u.ta = u.pm; u.tb = u.pn; u.k0 = 0; u.nt = ntk; u.ks = 0; u.sw = swapv && (u.pn == 5 || u.pn == 10); return true;
    }
};
struct SplitOrder {
    StaticOrder so; int G, c, with_ctx, ntk;
    __device__ __forceinline__ void init(int G_, int c_, int with_ctx_, int ntk_) { so.init(16384, 1024, G_, c_, ntk_); G = G_; c = c_; with_ctx = with_ctx_; ntk = ntk_; }
    __device__ __forceinline__ bool next(int i, Unit& u) const {
        const int L = i * G + c;
        int wgid = L < so.nwg ? L : 0; { const int q = so.nwg / NXCD, r = so.nwg % NXCD, xcd = wgid % NXCD, off = wgid / NXCD; wgid = (xcd < r ? xcd * (q + 1) : r * (q + 1) + (xcd - r) * q) + off; }
        const int nig = WGM * so.nN, gid = wgid / nig, fm = gid * WGM, gsz = (so.nM - fm) < WGM ? (so.nM - fm) : WGM;
        const int apm = fm + ((wgid % nig) % gsz), apn = (wgid % nig) / gsz;
        const int j = L - so.nwg, ks = j & 3;
        const int bpm = 64 + ((j >> 4) & 7), bpn = (j >> 2) & 3;
        const int bk0 = (ntk == 16) ? 4 * ks : (ks < 2 ? 12 * ks : 24 + 10 * (ks - 2)), bnt = (ntk == 16) ? 4 : (ks < 2 ? 12 : 10);
        const bool va = L < so.nwg, vb = (with_ctx != 0) && j >= 0 && j < 128;
        u.pm = va ? apm : bpm; u.pn = va ? apn : bpn; u.ta = u.pm; u.tb = u.pn; u.k0 = va ? 0 : bk0; u.nt = va ? ntk : bnt; u.ks = va ? 0 : ks; u.sw = 0;
        return va || vb;
    }
};
struct FourierOrder {
    int c, lat;
    __device__ __forceinline__ bool next(int i, Unit& u) const {
        if (i != 0) return false;
        if (lat) { if (c >= 64) return false; u.pm = c; u.pn = 0; u.ta = c & 7; u.tb = c >> 3; u.k0 = 0; u.nt = 32; u.ks = 0; u.sw = 0; return true; }
        if (c < 64 || c >= 72) return false; u.pm = 64 + (c - 64); u.pn = 0; u.ta = 0; u.tb = c - 64; u.k0 = 0; u.nt = 8; u.ks = 0; u.sw = 0; return true;
    }
};


struct EpiF32 {
    static constexpr bool PERM = true;
    bf16_t* O; int ldc, ntfull;
    __device__ __forceinline__ void operator()(const f32x4 (&acc)[2][2][4][2], const Unit& u, int wr, int wc, int fr, int fq) const {
        const int rshift = (u.nt == ntfull) ? 0 : u.ks * 2048;
        const int row0 = u.pm * BM + rshift + wr * 64 + fr, col0 = u.pn * BM + wc * 32 + 8 * fq;
#pragma unroll
        for (int ai = 0; ai < 2; ++ai)
#pragma unroll
            for (int m = 0; m < 4; ++m) { bf16_t* rowp = O + (size_t)(row0 + ai * HALF + m * 16) * ldc + col0;
#pragma unroll
                for (int bj = 0; bj < 2; ++bj) { const f32x4 v0 = acc[ai][bj][m][0], v1 = acc[ai][bj][m][1];
                    u32x4 w; w.x = pk2(v0[0], v0[1]); w.y = pk2(v0[2], v0[3]); w.z = pk2(v1[0], v1[1]); w.w = pk2(v1[2], v1[3]);
                    *(u32x4*)(rowp + bj * HALF) = w; } }
    }
};
struct EpiBf16S {
    static constexpr bool PERM = true;
    bf16_t* O; int ldc; float sc;
    __device__ __forceinline__ void operator()(const f32x4 (&acc)[2][2][4][2], const Unit& u, int wr, int wc, int fr, int fq) const {
        const int row0 = u.pm * BM + wr * 64 + fr, col0 = u.pn * BM + wc * 32 + 8 * fq;
#pragma unroll
        for (int ai = 0; ai < 2; ++ai)
#pragma unroll
            for (int m = 0; m < 4; ++m) { bf16_t* rowp = O + (size_t)(row0 + ai * HALF + m * 16) * ldc + col0;
#pragma unroll
                for (int bj = 0; bj < 2; ++bj) { const f32x4 v0 = acc[ai][bj][m][0] * sc, v1 = acc[ai][bj][m][1] * sc;
                    u32x4 w; w.x = pk2v(v0[0], v0[1]); w.y = pk2v(v0[2], v0[3]); w.z = pk2v(v1[0], v1[1]); w.w = pk2v(v1[2], v1[3]);
                    *(u32x4*)(rowp + bj * HALF) = w; } }
    }
};
struct EpiP {
    static constexpr bool PERM = true;
    bf16_t* P; bf16_t *vtrl, *vtrc, *vtnl, *vtnc;
    __device__ __forceinline__ void operator()(const f32x4 (&acc)[2][2][4][2], const Unit& u, int wr, int wc, int fr, int fq) const {
        if (u.sw) {
            const bool lat = u.pm < 64;
            bf16_t* base; int ld, t0;
            if (lat) { base = (u.pn == 5 ? vtrl : vtnl) + (size_t)(u.pm >> 3) * 4 * 64 * 2048; ld = 2048; t0 = (u.pm & 7) * 256; }
            else     { base = (u.pn == 5 ? vtrc : vtnc) + (size_t)(u.pm - 64) * 4 * 64 * 256; ld = 256; t0 = 0; }
#pragma unroll
            for (int ai = 0; ai < 2; ++ai)
#pragma unroll
                for (int m = 0; m < 4; ++m) { bf16_t* rowp = base + (size_t)(ai * HALF + wr * 64 + m * 16 + fr) * ld + t0 + wc * 32 + 8 * fq;
#pragma unroll
                    for (int bj = 0; bj < 2; ++bj) { const f32x4 v0 = acc[ai][bj][m][0], v1 = acc[ai][bj][m][1];
                        u32x4 w; w.x = pk2(v0[0], v0[1]); w.y = pk2(v0[2], v0[3]); w.z = pk2(v1[0], v1[1]); w.w = pk2(v1[2], v1[3]);
                        *(u32x4*)(rowp + bj * HALF) = w; } }
            return;
        }
        const int row0 = u.pm * BM + wr * 64 + fr, col0 = u.pn * BM + wc * 32 + 8 * fq;
#pragma unroll
        for (int ai = 0; ai < 2; ++ai)
#pragma unroll
            for (int m = 0; m < 4; ++m) { bf16_t* rowp = P + (size_t)(row0 + ai * HALF + m * 16) * DIN + col0;
#pragma unroll
                for (int bj = 0; bj < 2; ++bj) { const f32x4 v0 = acc[ai][bj][m][0], v1 = acc[ai][bj][m][1];
                    u32x4 w; w.x = pk2(v0[0], v0[1]); w.y = pk2(v0[2], v0[3]); w.z = pk2(v1[0], v1[1]); w.w = pk2(v1[2], v1[3]);
                    *(u32x4*)(rowp + bj * HALF) = w; } }
    }
};
struct EpiUp {
    static constexpr bool PERM = true;
    bf16_t* G; float* uB; const float* cw;
    __device__ __forceinline__ void operator()(const f32x4 (&acc)[2][2][4][2], const Unit& u, int wr, int wc, int fr, int fq) const {
        const int ch0 = u.pn * HALF + wc * 32 + 8 * fq;
        const bool edge = (fr < 2) || (fr >= 14); const bool lo = fr < 2;
        const int erow = lo ? fr : fr - 12;
#pragma unroll
        for (int ai = 0; ai < 2; ++ai) {
            const int blk = u.pm * 4 + ai * 2 + wr, rowb = blk * 64;
            float* ua = uB + ((size_t)blk * 4 + erow) * NUP + ch0; float* ub = ua + DFF;
            bf16_t* gp = G + (size_t)(rowb + fr) * DFF + ch0;
#pragma unroll
            for (int n = 0; n < 2; ++n) {
                if (edge) {
                    const f32x4 ea = lo ? acc[ai][0][0][n] : acc[ai][0][3][n], eb = lo ? acc[ai][1][0][n] : acc[ai][1][3][n];
                    *(f32x4*)(ua + 4 * n) = ea; *(f32x4*)(ub + 4 * n) = eb;
                }
                unsigned ow[4][2];
#pragma unroll
                for (int jp = 0; jp < 2; ++jp) {
                    const float* cwp = cw + ch0 + 4 * n + 2 * jp;
                    const f32x2_t wa0 = *(const f32x2_t*)(cwp), wa1 = *(const f32x2_t*)(cwp + NUP), wa2 = *(const f32x2_t*)(cwp + 2 * NUP);
                    const f32x2_t wb0 = *(const f32x2_t*)(cwp + DFF), wb1 = *(const f32x2_t*)(cwp + NUP + DFF), wb2 = *(const f32x2_t*)(cwp + 2 * NUP + DFF);
#pragma unroll
                    for (int m = 0; m < 4; ++m) {
                        float gv[2];
#pragma unroll
                        for (int jj = 0; jj < 2; ++jj) {
                            const int j = 2 * jp + jj;
                            const float a = acc[ai][0][m][n][j], b = acc[ai][1][m][n][j];
                            const float ap = (m > 0) ? acc[ai][0][m - 1][n][j] : 0.f, bp = (m > 0) ? acc[ai][1][m - 1][n][j] : 0.f;
                            const float an = (m < 3) ? acc[ai][0][m + 1][n][j] : 0.f, bn = (m < 3) ? acc[ai][1][m + 1][n][j] : 0.f;
                            const float ua_ = dpp_ror1(fr == 15 ? ap : a), ub_ = dpp_ror1(fr == 15 ? bp : b);
                            const float da = dpp_ror15(fr == 0 ? an : a), db = dpp_ror15(fr == 0 ? bn : b);
                            const float ca = wa0[jj] * ua_ + wa1[jj] * a + wa2[jj] * da;
                            const float cb = wb0[jj] * ub_ + wb1[jj] * b + wb2[jj] * db;
                            gv[jj] = silu_f(ca) * cb;
                        }
                        ow[m][jp] = pk2(gv[0], gv[1]);
                    }
                    asm volatile("" ::: "memory");
                }
#pragma unroll
                for (int m = 0; m < 4; ++m) { u32x2 w; w.x = ow[m][0]; w.y = ow[m][1]; *(u32x2*)(gp + (size_t)(m * 16) * DFF + 4 * n) = w; }
                asm volatile("" ::: "memory");
            }
        }
    }
};

template <class Epi, class Sched, bool ALIGN_EPI = false, bool SP2 = false>
__device__ __forceinline__ void gemm_phase(LAS unsigned char* lds, const Gemm g, const Sched& S, const Epi& E, const int tidx) {
    const int tid = tidx, wid = __builtin_amdgcn_readfirstlane(tid >> 6), lane = tid & 63, wr = wid >> 2, wc = wid & 3, fr = lane & 15, fq = lane >> 4;
    const int K = g.K;
    unsigned voffA[2], voffB[2];
#pragma unroll
    for (int i = 0; i < 2; ++i) { int R, C; stage_rc(tid * 16 + i * 8192, R, C); const int Rb = Epi::PERM ? ((R & ~31) + perm32(R & 31)) : R;
        voffA[i] = (unsigned)(R * K + C) * 2u; voffB[i] = (unsigned)(Rb * K + C) * 2u; }
    const size_t kstep = (size_t)(BK * 2);
    const size_t hstepA = g.hstepA, hstepB = g.hstepB;
    const unsigned ldsw = (unsigned)wid * 1024u;
    const int aoff = lds_byte(wr * 64 + fr, fq * 8), boff = lds_byte(wc * 32 + fr, fq * 8);
#define PG8_SA(b, h) (((b) * 2 + (h)) * HTB)
#define PG8_SB(b, h) ((4 + (b) * 2 + (h)) * HTB)
#define PG8_STAGE(bufoff, gbase, voff) do { _Pragma("unroll") for (int _i = 0; _i < 2; ++_i) \
        __builtin_amdgcn_global_load_lds((const unsigned*)((const char*)(gbase) + (voff)[_i]), (LAS unsigned*)(lds + (bufoff) + ldsw + _i * 8192), 16, 0, 0); } while (0)
#define PG8_LDA(dst, b, h) do { _Pragma("unroll") for (int m = 0; m < 4; ++m) _Pragma("unroll") for (int k = 0; k < 2; ++k) dst[m][k] = *(const LAS bf16x8*)(lds + PG8_SA(b, h) + aoff + m * 2048 + k * 1024); } while (0)
#define PG8_LDB(dst, b, h) do { _Pragma("unroll") for (int n = 0; n < 2; ++n) _Pragma("unroll") for (int k = 0; k < 2; ++k) dst[n][k] = *(const LAS bf16x8*)(lds + PG8_SB(b, h) + boff + n * 2048 + k * 1024); } while (0)
#define PG8_MMA(ai, bj, At, Bt) do { __builtin_amdgcn_s_setprio(1); _Pragma("unroll") for (int m = 0; m < 4; ++m) _Pragma("unroll") for (int n = 0; n < 2; ++n) _Pragma("unroll") for (int k = 0; k < 2; ++k) \
        acc[ai][bj][m][n] = __builtin_amdgcn_mfma_f32_16x16x32_bf16(Bt[n][k], At[m][k], acc[ai][bj][m][n], 0, 0, 0); __builtin_amdgcn_s_setprio(0); } while (0)
#define PG8_WAIT_V(n) asm volatile("s_waitcnt vmcnt(" #n ")" ::: "memory")
#define PG8_WAIT_L(n) asm volatile("s_waitcnt lgkmcnt(" #n ")" ::: "memory")
#define PG8_BAR __builtin_amdgcn_s_barrier()
#define PG8_SCHED __builtin_amdgcn_sched_barrier(0)
    Unit cur, nxt; int ui = 0;
    if (!S.next(0, cur)) return;
    f32x4 acc[2][2][4][2];
#pragma unroll
    for (int a = 0; a < 2; ++a)
#pragma unroll
        for (int b = 0; b < 2; ++b)
#pragma unroll
            for (int m = 0; m < 4; ++m)
#pragma unroll
                for (int n = 0; n < 2; ++n) acc[a][b][m][n] = (f32x4){0.f, 0.f, 0.f, 0.f};
    bf16x8 At[4][2], B0[2][2], B1[2][2];
#define PG8_UA(u) ((u).sw ? (const char*)g.Bt + (size_t)(u).tb * g.tstepB + (size_t)(u).k0 * (BK * 2) : (const char*)g.A + (size_t)(u).ta * g.tstepA + (size_t)(u).k0 * (BK * 2))
#define PG8_UB(u) ((u).sw ? (const char*)g.A + (size_t)(u).ta * g.tstepA + (size_t)(u).k0 * (BK * 2) : (const char*)g.Bt + (size_t)(u).tb * g.tstepB + (size_t)(u).k0 * (BK * 2))
    const char* cA = PG8_UA(cur); const char* cB = PG8_UB(cur);
    if constexpr (SP2) {
        PG8_STAGE(PG8_SB(0, 0), cB, voffB); PG8_STAGE(PG8_SB(0, 1), cB + hstepB, voffB); PG8_STAGE(PG8_SA(0, 0), cA, voffA); PG8_STAGE(PG8_SA(0, 1), cA + hstepA, voffA);
        if (wr == 1) PG8_BAR;
        PG8_WAIT_V(2); PG8_BAR;
        PG8_STAGE(PG8_SB(1, 0), cB + kstep, voffB); PG8_STAGE(PG8_SA(1, 0), cA + kstep, voffA); PG8_STAGE(PG8_SB(1, 1), cB + hstepB + kstep, voffB);
        PG8_WAIT_V(6); PG8_BAR;
    } else {
        PG8_STAGE(PG8_SB(0, 0), cB, voffB); PG8_STAGE(PG8_SA(0, 0), cA, voffA); PG8_STAGE(PG8_SB(0, 1), cB + hstepB, voffB); PG8_STAGE(PG8_SA(0, 1), cA + hstepA, voffA);
        if (wr == 1) PG8_BAR;
        PG8_WAIT_V(4); PG8_BAR;
        PG8_STAGE(PG8_SB(1, 0), cB + kstep, voffB); PG8_STAGE(PG8_SA(1, 0), cA + kstep, voffA); PG8_STAGE(PG8_SB(1, 1), cB + hstepB + kstep, voffB);
        PG8_WAIT_V(6); PG8_BAR;
    }
    for (;;) {
        const bool has_next = S.next(ui + 1, nxt);
        const char* nA = has_next ? PG8_UA(nxt) : cA; const char* nB = has_next ? PG8_UB(nxt) : cB;
        const int nt = cur.nt;
        for (int t = 0; t < nt; t += 2) {
            const bool last = (t == nt - 2);
            const char* a1 = cA + (size_t)(t + 1) * kstep;
            const char* a2 = last ? nA : cA + (size_t)(t + 2) * kstep; const char* b2 = last ? nB : cB + (size_t)(t + 2) * kstep;
            const char* a3 = a2 + kstep; const char* b3 = b2 + kstep;
            if constexpr (SP2) {
            PG8_LDB(B0, 0, 0); PG8_LDB(B1, 0, 1); PG8_SCHED; PG8_LDA(At, 0, 0); PG8_STAGE(PG8_SA(1, 1), a1 + hstepA, voffA);
            PG8_WAIT_V(8); PG8_WAIT_L(0); PG8_BAR; PG8_MMA(0, 0, At, B0); PG8_MMA(0, 1, At, B1); PG8_BAR; PG8_SCHED;
            PG8_LDA(At, 0, 1); PG8_STAGE(PG8_SB(0, 0), b2, voffB); PG8_STAGE(PG8_SB(0, 1), b2 + hstepB, voffB); PG8_STAGE(PG8_SA(0, 0), a2, voffA);
            PG8_WAIT_V(8); PG8_WAIT_L(0); PG8_BAR; PG8_MMA(1, 0, At, B0); PG8_MMA(1, 1, At, B1); PG8_BAR; PG8_SCHED;
            PG8_LDB(B0, 1, 0); PG8_LDB(B1, 1, 1); PG8_SCHED; PG8_LDA(At, 1, 0); PG8_STAGE(PG8_SA(0, 1), a2 + hstepA, voffA);
            PG8_WAIT_V(8); PG8_WAIT_L(0); PG8_BAR; PG8_MMA(0, 0, At, B0); PG8_MMA(0, 1, At, B1); PG8_BAR; PG8_SCHED;
            PG8_LDA(At, 1, 1); PG8_STAGE(PG8_SB(1, 0), b3, voffB); PG8_STAGE(PG8_SB(1, 1), b3 + hstepB, voffB); PG8_STAGE(PG8_SA(1, 0), a3, voffA);
            PG8_WAIT_V(8); PG8_WAIT_L(0); PG8_BAR; PG8_MMA(1, 0, At, B0); PG8_MMA(1, 1, At, B1); PG8_BAR; PG8_SCHED;
            } else {
            PG8_LDB(B0, 0, 0); PG8_SCHED; PG8_LDA(At, 0, 0); PG8_STAGE(PG8_SA(1, 1), a1 + hstepA, voffA);
            PG8_WAIT_L(8); PG8_BAR; PG8_WAIT_L(0); PG8_MMA(0, 0, At, B0); PG8_BAR; PG8_SCHED;
            PG8_LDB(B1, 0, 1); PG8_STAGE(PG8_SB(0, 0), b2, voffB);
            PG8_BAR; PG8_WAIT_L(0); PG8_MMA(0, 1, At, B1); PG8_BAR;
            PG8_LDA(At, 0, 1); PG8_STAGE(PG8_SA(0, 0), a2, voffA);
            PG8_BAR; PG8_WAIT_L(0); PG8_MMA(1, 0, At, B0); PG8_BAR; PG8_SCHED;
            PG8_STAGE(PG8_SB(0, 1), b2 + hstepB, voffB);
            PG8_WAIT_V(6); PG8_BAR; PG8_MMA(1, 1, At, B1); PG8_BAR;
            PG8_LDB(B0, 1, 0); PG8_SCHED; PG8_LDA(At, 1, 0); PG8_STAGE(PG8_SA(0, 1), a2 + hstepA, voffA);
            PG8_WAIT_L(8); PG8_BAR; PG8_WAIT_L(0); PG8_MMA(0, 0, At, B0); PG8_BAR; PG8_SCHED;
            PG8_LDB(B1, 1, 1); PG8_STAGE(PG8_SB(1, 0), b3, voffB);
            PG8_BAR; PG8_WAIT_L(0); PG8_MMA(0, 1, At, B1); PG8_BAR;
            PG8_LDA(At, 1, 1); PG8_STAGE(PG8_SA(1, 0), a3, voffA);
            PG8_BAR; PG8_WAIT_L(0); PG8_MMA(1, 0, At, B0); PG8_BAR; PG8_SCHED;
            PG8_STAGE(PG8_SB(1, 1), b3 + hstepB, voffB);
            PG8_WAIT_V(6); PG8_BAR; PG8_MMA(1, 1, At, B1); PG8_BAR;
            }
        }
        if constexpr (ALIGN_EPI) { if (wr == 0) PG8_BAR; }
        E(acc, cur, wr, wc, fr, fq);
        if (!has_next) break;
#pragma unroll
        for (int a = 0; a < 2; ++a)
#pragma unroll
            for (int b = 0; b < 2; ++b)
#pragma unroll
                for (int m = 0; m < 4; ++m)
#pragma unroll
                    for (int n = 0; n < 2; ++n) acc[a][b][m][n] = (f32x4){0.f, 0.f, 0.f, 0.f};
        cur = nxt; cA = nA; cB = nB; ++ui;
        if constexpr (ALIGN_EPI) { if (wr == 1) PG8_BAR; }
    }
    PG8_WAIT_V(0);
    if constexpr (!ALIGN_EPI) { if (wr == 0) PG8_BAR; }
    PG8_BAR;
#undef PG8_SA
#undef PG8_SB
#undef PG8_STAGE
#undef PG8_LDA
#undef PG8_LDB
#undef PG8_MMA
#undef PG8_WAIT_V
#undef PG8_WAIT_L
#undef PG8_BAR
#undef PG8_SCHED
}
}

#define XB_TMO      128
#define XB_XCNT(j)  (256  + 64 * (j))
#define XB_XSUB(j)  (1280 + 64 * (j))
#define XB_XGEN(j)  (2304 + 64 * (j))
#define XB_TOP      3328
#define XB_TOPGEN   3392
#define XCD_BAR_WORDS 3456
#define XB_SPIN_CAP (1u << 18)

__device__ __forceinline__ unsigned xb_ld(unsigned* p)              { return __hip_atomic_load(p, __ATOMIC_RELAXED, __HIP_MEMORY_SCOPE_AGENT); }
__device__ __forceinline__ unsigned xb_add(unsigned* p, unsigned v) { return __hip_atomic_fetch_add(p, v, __ATOMIC_RELAXED, __HIP_MEMORY_SCOPE_AGENT); }
__device__ __forceinline__ unsigned xb_xcc_id() { return (unsigned)__builtin_amdgcn_s_getreg((3 << 11) | 20) & 0xFu; }
#define XB_SPIN(cond, bar) do { unsigned _sp = 0; while (cond) { __builtin_amdgcn_s_sleep(1); \
    if ((++_sp & 255u) == 0u) { if (xb_ld(&(bar)[XB_TMO])) break; if (_sp > XB_SPIN_CAP) { atomicAdd(&(bar)[XB_TMO], 1u); break; } } } } while (0)

struct XcdBarrier {
    unsigned* bar; unsigned x;
    volatile LAS unsigned* st;
};

__device__ __forceinline__ XcdBarrier xcd_barrier_post(unsigned* bar, volatile LAS unsigned* st) {
    XcdBarrier b; b.bar = bar; b.x = xb_xcc_id(); b.st = st;
    if (threadIdx.x == 0) (void)xb_add(&bar[XB_XCNT(b.x)], 1u);
    return b;
}
__device__ __forceinline__ void xcd_barrier_complete(unsigned* bar, unsigned x, unsigned& nloc, unsigned& nx) {
    const unsigned G = gridDim.x * gridDim.y * gridDim.z;
    unsigned sum, cnt, mine, sp = 0u;
    for (;;) {
        sum = 0u; cnt = 0u; mine = 0u;
#pragma unroll
        for (unsigned j = 0; j < 16; ++j) { const unsigned c = xb_ld(&bar[XB_XCNT(j)]); sum += c; cnt += (c > 0u) ? 1u : 0u; mine = (j == x) ? c : mine; }
        if (sum == G) break;
        __builtin_amdgcn_s_sleep(1);
        if ((++sp & 255u) == 0u) { if (xb_ld(&bar[XB_TMO])) break; if (sp > XB_SPIN_CAP) { atomicAdd(&bar[XB_TMO], 1u); break; } }
    }
    nloc = mine > 0u ? mine : 1u; nx = cnt > 0u ? cnt : 1u;
}

__device__ __forceinline__ void xcd_barrier(const XcdBarrier& b) {
    asm volatile("s_waitcnt vmcnt(0)" ::: "memory");
    __syncthreads();
    if (threadIdx.x == 0) {
        unsigned* bar = b.bar;
        __builtin_amdgcn_s_waitcnt(0);
        unsigned nloc = b.st[0], nx = b.st[1];
        if (nloc == 0u) { xcd_barrier_complete(bar, b.x, nloc, nx); b.st[0] = nloc; b.st[1] = nx; }
        const unsigned old = xb_add(&bar[XB_XSUB(b.x)], 1u);
        const unsigned gen = old / nloc;
        if (old + 1u == (gen + 1u) * nloc) {
            __builtin_amdgcn_fence(__ATOMIC_RELEASE, "agent");
            asm volatile("s_waitcnt vmcnt(0)" ::: "memory");
            const unsigned og = xb_add(&bar[XB_TOP], 1u);
            const unsigned tg = og / nx;
            if (og + 1u == (tg + 1u) * nx) xb_add(&bar[XB_TOPGEN], 1u);
            else XB_SPIN(xb_ld(&bar[XB_TOPGEN]) == tg, bar);
            __builtin_amdgcn_fence(__ATOMIC_ACQUIRE, "agent");
            xb_add(&bar[XB_XGEN(b.x)], 1u);
            asm volatile("s_waitcnt vmcnt(0)" ::: "memory");
        } else {
            XB_SPIN(xb_ld(&bar[XB_XGEN(b.x)]) == gen, bar);
            __builtin_amdgcn_fence(__ATOMIC_ACQUIRE, "agent");
            asm volatile("s_waitcnt vmcnt(0)" ::: "memory");
        }
    }
    __syncthreads();
}

#ifndef PHMASK
#define PHMASK 0xFFFFF
#endif
#define PHON(k) ((PHMASK >> (k)) & 1)
struct Args { const float* in[18]; float* out; unsigned char* ws; };
enum { I_X = 0, I_C, I_CTX, I_CCTX, I_WMOD, I_BMOD, I_GPREMIX, I_GPOSTMIX, I_GPREFFN, I_GPOSTFFN, I_WIN, I_WOUT, I_CONVW, I_RETDECAY, I_RPB, I_WUP, I_FFNCONVW, I_WDOWN };

DI void transpose_item(const float* W, int K, int N, bf16_t* WT, LAS float* scr, int item, int lane) {
    const int nblk = N / 32, kb = item / nblk, nb = item % nblk, k0 = 64 * kb, n0 = 32 * nb;
#pragma unroll 8
    for (int i = 0; i < 32; ++i) { const int kk = 2 * i + (lane >> 5); scr[kk * 33 + (lane & 31)] = __builtin_nontemporal_load(W + (size_t)(k0 + kk) * N + n0 + (lane & 31)); }
    asm volatile("s_waitcnt lgkmcnt(0)" ::: "memory");
    const int c = lane & 7;
#pragma unroll
    for (int j = 0; j < 4; ++j) { const int n = (lane >> 3) + 8 * j; const LAS float* s = scr + (8 * c) * 33 + n;
        u32x4 o; o.x = pk2(s[0 * 33], s[1 * 33]); o.y = pk2(s[2 * 33], s[3 * 33]); o.z = pk2(s[4 * 33], s[5 * 33]); o.w = pk2(s[6 * 33], s[7 * 33]);
        *(u32x4*)(WT + (size_t)(n0 + n) * K + k0 + 8 * c) = o; }
    asm volatile("s_waitcnt lgkmcnt(0)" ::: "memory");
}
DI void convert_weight(const float* W, int K, int N, bf16_t* WT, LAS unsigned char* L, int gw, int ngw, int lane, int wave) {
    LAS float* scr = (LAS float*)(L + wave * 8704);
    const int nitems = (K / 64) * (N / 32);
    for (int it = gw; it < nitems; it += ngw) transpose_item(W, K, N, WT, scr, it, lane);
}

struct ConvJob { const float* W; bf16_t* WT; int K, N; };
template <int NJ>
DI void filler_convert(const ConvJob (&jobs)[NJ], unsigned* ctr, LAS unsigned char* L, int tid, int lane, int wave) {
    int cnt[NJ], total = 0;
#pragma unroll
    for (int j = 0; j < NJ; ++j) { cnt[j] = jobs[j].W ? (jobs[j].K / 64) * (jobs[j].N / 32) : 0; total += cnt[j]; }
    LAS int* bw = (LAS int*)(L + 140000);
    LAS float* scr = (LAS float*)(L + wave * 8704);
    for (;;) {
        __syncthreads();
        if (tid == 0) *bw = (int)atomicAdd(ctr, 8u);
        __syncthreads();
        const int base = __builtin_amdgcn_readfirstlane(*bw);
        if (base >= total) break;
        int it = base + wave;
        if (it < total) {
#pragma unroll
            for (int j = 0; j < NJ; ++j) { if (it >= 0 && it < cnt[j]) transpose_item(jobs[j].W, jobs[j].K, jobs[j].N, jobs[j].WT, scr, it, lane); it -= cnt[j]; }
        }
    }
}
constexpr size_t WOFF_IN = 0, WOFF_OUT = (size_t)DIN * DM, WOFF_UP = WOFF_OUT + (size_t)DM * DM, WOFF_DN = WOFF_UP + (size_t)NUP * DM;
static_assert(WS_WOUT - WS_WIN == WOFF_OUT * 2 && WS_WUP - WS_WIN == WOFF_UP * 2 && WS_WDN - WS_WIN == WOFF_DN * 2, "weight set layout");
#define WSET(l_) ((bf16_t*)(((l_) & 1) ? (unsigned char*)a.out : ws + WS_WIN))

template <class ArgsT> DI void mods_phase(const ArgsT& a, LAS unsigned char* L, float* mods, const int tidx) {
    LAS float* sc = (LAS float*)L;
    LAS float* red = (LAS float*)(L + 9 * 1024 * 4);
    const int tid = tidx, lane = tid & 63, wave = tid >> 6;
    for (int i = tid; i < 9 * 1024; i += NTHREADS) { const float v = (i < 8192) ? a.in[I_C][i] : a.in[I_CCTX][i - 8192]; sc[i] = silu_f(v); }
    __syncthreads();
    for (int it = blockIdx.x; it < 4 * 48; it += gridDim.x) {
        const int l = it / 48, n0 = (it % 48) * 128;
        const float* W = a.in[I_WMOD] + (size_t)l * 1024 * 6144 + n0 + lane * 2;
        f32x2_t acc[9];
#pragma unroll
        for (int i = 0; i < 9; ++i) acc[i] = (f32x2_t){0.f, 0.f};
#pragma unroll 1
        for (int k0 = wave * 128; k0 < wave * 128 + 128; k0 += 8) {
            f32x2_t w[8];
#pragma unroll
            for (int kk = 0; kk < 8; ++kk) w[kk] = __builtin_nontemporal_load((const f32x2_t*)(W + (size_t)(k0 + kk) * 6144));
#pragma unroll
            for (int kk = 0; kk < 8; ++kk)
#pragma unroll
                for (int i = 0; i < 9; ++i) acc[i] += sc[i * 1024 + k0 + kk] * w[kk];
        }
#pragma unroll
        for (int i = 0; i < 9; ++i) *(LAS f32x2_t*)(red + (wave * 9 + i) * 128 + lane * 2) = acc[i];
        __syncthreads();
        for (int o = tid; o < 9 * 128; o += NTHREADS) { const int i = o >> 7, c = o & 127; float s = 0.f;
#pragma unroll
            for (int w = 0; w < 8; ++w) s += red[(w * 9 + i) * 128 + c];
            mods[(size_t)(l * 9 + i) * 6144 + n0 + c] = s + a.in[I_BMOD][l * 6144 + n0 + c]; }
        __syncthreads();
    }
}

DI void tables_phase(unsigned char* ws, const int tidx) {
    const size_t gt = (size_t)blockIdx.x * NTHREADS + tidx, ngt = (size_t)gridDim.x * NTHREADS;
    bf16_t* dft = (bf16_t*)(ws + WS_DFT);
    for (size_t i = gt; i < (size_t)2048 * 2048 / 8; i += ngt) {
        const int k = (int)(i / 256), n8 = (int)(i % 256) * 8; float v[8];
#pragma unroll
        for (int j = 0; j < 8; ++j) { const int nn = n8 + j, n = nn & 1023; const int m = (k * n) & 2047; const float x = (float)m * (1.0f / 1024.0f);
            v[j] = (nn < 1024) ? cospif(x) : (n == 0 ? ((k & 1) ? -1.0f : 1.0f) : -sinpif(x)); }
        u32x4 o; o.x = pk2(v[0], v[1]); o.y = pk2(v[2], v[3]); o.z = pk2(v[4], v[5]); o.w = pk2(v[6], v[7]);
        *(u32x4*)(dft + i * 8) = o;
    }
    bf16_t* dftc = (bf16_t*)(ws + WS_DFTC);
    for (size_t i = gt; i < (size_t)256 * 512 / 8; i += ngt) {
        const int k = (int)(i / 64), n8 = (int)(i % 64) * 8; float v[8];
#pragma unroll
        for (int j = 0; j < 8; ++j) { const int nn = n8 + j, n = nn & 255; const int m = (k * n) & 255; const float x = (float)m * (1.0f / 128.0f); v[j] = (nn < 256) ? cospif(x) : -sinpif(x); }
        u32x4 o; o.x = pk2(v[0], v[1]); o.y = pk2(v[2], v[3]); o.z = pk2(v[4], v[5]); o.w = pk2(v[6], v[7]);
        *(u32x4*)(dftc + i * 8) = o;
    }
    bf16_t* cm = (bf16_t*)(ws + WS_CMAT);
    for (size_t i = gt; i < 128 * 64; i += ngt) { const int jr = (int)i / 64, c = (int)i % 64, j = jr & 63; const int m = (j * c) & 63; const float x = (float)m * (1.0f / 32.0f);
        const float v = (jr < 64) ? cospif(x) : sinpif(x); cm[i] = (bf16_t)(pk2(v, 0.f) & 0xffffu); }
    float* rc = (float*)(ws + WS_ROPE); float* rs = rc + 2048 * 32;
    for (size_t i = gt; i < 2048 * 32; i += ngt) { const int t = (int)i / 32, f = (int)i % 32; const float inv = powf(10000.0f, -(float)(f & 15) / 16.0f);
        const float pos = (f < 16) ? (float)(t / 64) : (float)(t % 64); const float ang = pos * inv; rc[i] = cosf(ang); rs[i] = sinf(ang); }
}

template <bool XIN16, bool XOUT16>
DI void rowwise_phase(const float* xin_lat, const float* xin_ctx, float* xout_lat, bf16_t* xb, const bf16_t* o, const float* gpost, const float* mod_gate  ,
                      const float* gpre, const float* mod_sc, const float* mod_sh, bf16_t* hout, int nrows, const int tidx) {
    const bool aff = (gridDim.x % 8) == 0;
    const int lane = tidx & 63, xcd = aff ? (int)(blockIdx.x & 7) : 0;
    const int gw = aff ? (int)(blockIdx.x >> 3) * 8 + (tidx >> 6) : (int)blockIdx.x * 8 + (tidx >> 6), ngw = aff ? (int)(gridDim.x >> 3) * 8 : (int)gridDim.x * 8;
    const int nloc = aff ? (nrows > TL ? 2304 : 2048) : nrows;
    constexpr int NR = 3;
    for (int r0 = gw; r0 < nloc; r0 += NR * ngw) {
        int rr[NR]; bool ok[NR];
#pragma unroll
        for (int k = 0; k < NR; ++k) { int i = r0 + k * ngw; ok[k] = i < nloc; if (!ok[k]) i = r0; rr[k] = !aff ? i : (i < 2048 ? xcd * 2048 + i : TL + xcd * 256 + (i - 2048)); }
        f32x4 x[NR][4], ov[NR][4];
#pragma unroll
        for (int k = 0; k < NR; ++k) {
            const int r = rr[k]; const bool lat = r < TL;
            if (XIN16) {
#pragma unroll
                for (int j = 0; j < 4; ++j) { const u32x2 w0 = *(const u32x2*)(xb + (size_t)r * DM + lane * 4 + 256 * j); x[k][j] = (f32x4){hlo(w0.x), hhi(w0.x), hlo(w0.y), hhi(w0.y)}; }
            } else {
                const float* xi = lat ? xin_lat + (size_t)r * DM : xin_ctx + (size_t)(r - TL) * DM;
#pragma unroll
                for (int j = 0; j < 4; ++j) x[k][j] = __builtin_nontemporal_load((const f32x4*)(xi + lane * 4 + 256 * j));
            }
            if (o) {
#pragma unroll
                for (int j = 0; j < 4; ++j) { const u32x2 w0 = __builtin_nontemporal_load((const u32x2*)(o + (size_t)r * DM + lane * 4 + 256 * j)); ov[k][j] = (f32x4){bflo(w0.x), bfhi(w0.x), bflo(w0.y), bfhi(w0.y)}; }
                if (!lat) {
#pragma unroll
                    for (int ks = 1; ks < 4; ++ks)
#pragma unroll
                        for (int j = 0; j < 4; ++j) { const u32x2 wk = __builtin_nontemporal_load((const u32x2*)(o + (size_t)(r + ks * TC) * DM + lane * 4 + 256 * j)); ov[k][j] += (f32x4){bflo(wk.x), bfhi(wk.x), bflo(wk.y), bfhi(wk.y)}; }
                }
            }
        }
#pragma unroll
        for (int k = 0; k < NR; ++k) {
            const int r = rr[k]; const bool lat = r < TL; const int bi = lat ? (r >> 11) : 8;
            if (o) {
                float ss = 0.f;
#pragma unroll
                for (int j = 0; j < 4; ++j) ss += ov[k][j].x * ov[k][j].x + ov[k][j].y * ov[k][j].y + ov[k][j].z * ov[k][j].z + ov[k][j].w * ov[k][j].w;
                const float rstd = rsqrtf(wave_sum(ss) * (1.0f / DM) + EPSV);
#pragma unroll
                for (int j = 0; j < 4; ++j) { const f32x4 gp = *(const f32x4*)(gpost + lane * 4 + 256 * j), gt = *(const f32x4*)(mod_gate + (size_t)bi * 6144 + lane * 4 + 256 * j);
                    x[k][j] = x[k][j] + gt * (ov[k][j] * rstd * gp); }
            }
            if (XOUT16) {
                if (ok[k]) {
#pragma unroll
                    for (int j = 0; j < 4; ++j) { u32x2 w; w.x = pkh2(x[k][j].x, x[k][j].y); w.y = pkh2(x[k][j].z, x[k][j].w); *(u32x2*)(xb + (size_t)r * DM + lane * 4 + 256 * j) = w; }
                }
            } else if (xout_lat && ok[k] && lat) {
#pragma unroll
                for (int j = 0; j < 4; ++j) __builtin_nontemporal_store(x[k][j], (f32x4*)(xout_lat + (size_t)r * DM + lane * 4 + 256 * j));
            }
            if (hout) {
                float ss = 0.f;
#pragma unroll
                for (int j = 0; j < 4; ++j) ss += x[k][j].x * x[k][j].x + x[k][j].y * x[k][j].y + x[k][j].z * x[k][j].z + x[k][j].w * x[k][j].w;
                const float rstd = rsqrtf(wave_sum(ss) * (1.0f / DM) + EPSV);
                if (ok[k]) {
#pragma unroll
                    for (int j = 0; j < 4; ++j) { const f32x4 gp = *(const f32x4*)(gpre + lane * 4 + 256 * j), sc = *(const f32x4*)(mod_sc + (size_t)bi * 6144 + lane * 4 + 256 * j), sh = *(const f32x4*)(mod_sh + (size_t)bi * 6144 + lane * 4 + 256 * j);
                        const f32x4 hv = (x[k][j] * rstd * gp) * (1.0f + sc) + sh;
                        u32x2 w; w.x = pk2(hv.x, hv.y); w.y = pk2(hv.z, hv.w);
                        *(u32x2*)(hout + (size_t)r * DM + lane * 4 + 256 * j) = w; }
                }
            }
        }
    }
}

DI void chdft_phase(const bf16_t* p, const bf16_t* cmat, bf16_t* zt, bf16_t* zct, bool with_ctx, int gw, int ngw, int lane) {
    const int nlat = TL / 32, ntask = nlat + (with_ctx ? TC / 16 : 0), l15 = lane & 15, q = lane >> 4;
    for (int task = gw; task < ntask; task += ngw) {
        if (task < nlat) {
            const int b = task >> 6, n0 = (task & 63) * 16;
            bf16_t* zb = zt + (size_t)b * 256 * 2048;
            const bf16_t* src = p + (size_t)(b * 2048 + n0 + l15) * DIN + 1792 + q * 8;
            const bf16_t* srm = p + (size_t)(b * 2048 + 2048 - n0 - l15) * DIN + 1792 + q * 8;
            const bf16_t* srh = p + (size_t)(b * 2048 + 1024 + l15) * DIN + 1792 + q * 8;
            const bool first = (n0 == 0);
#pragma unroll 1
            for (int g = 0; g < 4; ++g) {
                const bf16x8 a0 = ld8(src + g * 64), a1 = ld8(src + g * 64 + 32), m0 = ld8(srm + g * 64), m1 = ld8(srm + g * 64 + 32);
                bf16x8 h0 = a0, h1 = a1; if (first) { h0 = ld8(srh + g * 64); h1 = ld8(srh + g * 64 + 32); }
                float sp[4] = {0.f, 0.f, 0.f, 0.f};
#pragma unroll
                for (int jt = 0; jt < 8; ++jt) {
                    const bf16x8 c0 = ld8(cmat + (jt * 16 + l15) * 64 + q * 8), c1 = ld8(cmat + (jt * 16 + l15) * 64 + 32 + q * 8);
                    f32x4 acc = {0.f, 0.f, 0.f, 0.f}, acm = {0.f, 0.f, 0.f, 0.f};
                    acc = mfma16(a0, c0, acc); acc = mfma16(a1, c1, acc);
                    acm = mfma16(m0, c0, acm); acm = mfma16(m1, c1, acm);
                    if (first && q == 0) acm[0] = 0.f;
                    f32x4 v = (jt < 4) ? acc + acm : acc - acm;
                    if (first) {
                        if (jt < 4) { f32x4 ah = {0.f, 0.f, 0.f, 0.f}; ah = mfma16(h0, c0, ah); ah = mfma16(h1, c1, ah); sp[jt & 3] = ah[0]; }
                        else if (q == 0) v[0] = sp[jt & 3];
                    }
                    u32x2 w; w.x = pk2(v[0], v[1]); w.y = pk2(v[2], v[3]);
                    *(u32x2*)(zb + (size_t)(g * 64 + (jt & 3) * 16 + l15) * 2048 + (jt >> 2) * 1024 + n0 + q * 4) = w;
                }
            }
        } else {
            const int tok0 = TL + (task - nlat) * 16;
            const int b = (tok0 - TL) >> 8; bf16_t* zb = zct + (size_t)b * 256 * 512; const int n0 = (tok0 - TL) & 255;
            const bf16_t* src = p + (size_t)(tok0 + l15) * DIN + 1792 + q * 8;
#pragma unroll
            for (int g = 0; g < 4; ++g) {
                const bf16x8 a0 = ld8(src + g * 64), a1 = ld8(src + g * 64 + 32);
#pragma unroll
                for (int jt = 0; jt < 8; ++jt) {
                    const bf16x8 c0 = ld8(cmat + (jt * 16 + l15) * 64 + q * 8), c1 = ld8(cmat + (jt * 16 + l15) * 64 + 32 + q * 8);
                    f32x4 acc = {0.f, 0.f, 0.f, 0.f};
                    acc = mfma16(a0, c0, acc); acc = mfma16(a1, c1, acc);
                    u32x2 w; w.x = pk2(acc[0], acc[1]); w.y = pk2(acc[2], acc[3]);
                    *(u32x2*)(zb + (size_t)(g * 64 + (jt & 3) * 16 + l15) * 512 + (jt >> 2) * 256 + n0 + q * 4) = w;
                }
            }
        }
    }
}
DI void sconv_item(const bf16_t* p, const float* cw  , bf16_t* y, int row0  , const int tidx) {
#pragma unroll 2
    for (int idx = row0 * 32 + tidx; idx < (row0 + 64) * 32; idx += NTHREADS) {
        const int r = idx >> 5, c0 = (idx & 31) * 8;
        int t, len; if (r < TL) { t = r & 2047; len = 2048; } else { t = (r - TL) & 255; len = 256; }
        const bf16_t* pr = p + (size_t)r * DIN + c0;
        float s[8];
#pragma unroll
        for (int e = 0; e < 8; ++e) s[e] = 0.f;
#pragma unroll
        for (int d = -1; d <= 1; ++d) {
            if (t + d < 0 || t + d >= len) continue;
            const u32x4 uu = *(const u32x4*)(pr + (long)d * DIN), gg = *(const u32x4*)(pr + (long)d * DIN + 512);
            const f32x4 w0 = *(const f32x4*)(cw + (d + 1) * 256 + c0), w1 = *(const f32x4*)(cw + (d + 1) * 256 + c0 + 4);
            s[0] += w0[0] * bflo(uu.x) * bflo(gg.x); s[1] += w0[1] * bfhi(uu.x) * bfhi(gg.x);
            s[2] += w0[2] * bflo(uu.y) * bflo(gg.y); s[3] += w0[3] * bfhi(uu.y) * bfhi(gg.y);
            s[4] += w1[0] * bflo(uu.z) * bflo(gg.z); s[5] += w1[1] * bfhi(uu.z) * bfhi(gg.z);
            s[6] += w1[2] * bflo(uu.w) * bflo(gg.w); s[7] += w1[3] * bfhi(uu.w) * bfhi(gg.w);
        }
        const u32x4 bb = *(const u32x4*)(pr + 256);
        u32x4 o; o.x = pk2(s[0] * bflo(bb.x), s[1] * bfhi(bb.x)); o.y = pk2(s[2] * bflo(bb.y), s[3] * bfhi(bb.y));
        o.z = pk2(s[4] * bflo(bb.z), s[5] * bfhi(bb.z)); o.w = pk2(s[6] * bflo(bb.w), s[7] * bfhi(bb.w));
        *(u32x4*)(y + (size_t)r * DM + c0) = o;
    }
}
DI void load_rope16(const bf16_t* src  , int seg, bool lat, const float* rc, const float* rs, int tpos, float (&v)[16]) {
    const u32x4 o0 = *(const u32x4*)(src + seg * 16), o1 = *(const u32x4*)(src + seg * 16 + 8);
    v[0] = bflo(o0.x); v[1] = bfhi(o0.x); v[2] = bflo(o0.y); v[3] = bfhi(o0.y); v[4] = bflo(o0.z); v[5] = bfhi(o0.z); v[6] = bflo(o0.w); v[7] = bfhi(o0.w);
    v[8] = bflo(o1.x); v[9] = bfhi(o1.x); v[10] = bflo(o1.y); v[11] = bfhi(o1.y); v[12] = bflo(o1.z); v[13] = bfhi(o1.z); v[14] = bflo(o1.w); v[15] = bfhi(o1.w);
    if (lat) {
        const u32x4 p0 = *(const u32x4*)(src + (seg ^ 2) * 16), p1 = *(const u32x4*)(src + (seg ^ 2) * 16 + 8);
        float pv[16];
        pv[0] = bflo(p0.x); pv[1] = bfhi(p0.x); pv[2] = bflo(p0.y); pv[3] = bfhi(p0.y); pv[4] = bflo(p0.z); pv[5] = bfhi(p0.z); pv[6] = bflo(p0.w); pv[7] = bfhi(p0.w);
        pv[8] = bflo(p1.x); pv[9] = bfhi(p1.x); pv[10] = bflo(p1.y); pv[11] = bfhi(p1.y); pv[12] = bflo(p1.z); pv[13] = bfhi(p1.z); pv[14] = bflo(p1.w); pv[15] = bfhi(p1.w);
        const float sgn = (seg < 2) ? -1.f : 1.f;
        const float* c = rc + tpos * 32 + (seg & 1) * 16; const float* s = rs + tpos * 32 + (seg & 1) * 16;
#pragma unroll
        for (int e4 = 0; e4 < 4; ++e4) { const f32x4 cv = *(const f32x4*)(c + e4 * 4), sv = *(const f32x4*)(s + e4 * 4);
#pragma unroll
            for (int e = 0; e < 4; ++e) v[e4 * 4 + e] = v[e4 * 4 + e] * cv[e] + sgn * pv[e4 * 4 + e] * sv[e]; }
    }
}
DI void retkv_phase(const bf16_t* p, const bf16_t* vtl, const bf16_t* vtc, const float* rope, const float* decay  , float* kv, LAS unsigned char* L, const int tidx, unsigned* dyn) {
    const int tid = tidx, lane = tid & 63, wave = tid >> 6, l15 = lane & 15, q = lane >> 4;
    LAS bf16_t* kf = (LAS bf16_t*)L;
    LAS bf16_t* kb = kf + 64 * 136;
    LAS int* bwk = (LAS int*)(L + 140000);
    for (;;) {
        __syncthreads(); if (tid == 0) *bwk = (int)atomicAdd(dyn, 1u); __syncthreads();
        const int it = __builtin_amdgcn_readfirstlane(*bwk);
        if (it >= 8 * 4 * 18) break;
        const int b = it / 72, h = (it / 18) & 3, n = it % 18; const bool lat = n < 16;
        const int row0 = lat ? b * 2048 + n * 128 : TL + b * 256 + (n - 16) * 128;
        const float lgf = -__expf(decay[h]), lgb = -__expf(decay[4 + h]);
        {
            const int j = tid >> 2, seg = tid & 3; float v[16];
            load_rope16(p + (size_t)(row0 + j) * DIN + 1024 + h * 64, seg, lat, rope, rope + 2048 * 32, n * 128 + j, v);
            const float wf = 0.125f * __expf(lgf * (float)(127 - j)), wb = 0.125f * __expf(lgb * (float)j);
#pragma unroll
            for (int e = 0; e < 16; ++e) { kf[(seg * 16 + e) * 136 + j] = (bf16_t)(pk2(v[e] * wf, 0.f) & 0xffffu); kb[(seg * 16 + e) * 136 + j] = (bf16_t)(pk2(v[e] * wb, 0.f) & 0xffffu); }
        }
        __syncthreads();
        {
            const int dir = wave >> 2, et = wave & 3;
            const bf16_t* vsrc = lat ? vtl + ((size_t)(b * 4 + h) * 64 + et * 16 + l15) * 2048 + n * 128 : vtc + ((size_t)(b * 4 + h) * 64 + et * 16 + l15) * 256 + (n - 16) * 128;
            LAS bf16_t* ks = dir ? kb : kf;
            f32x4 acc[4];
#pragma unroll
            for (int dt = 0; dt < 4; ++dt) acc[dt] = (f32x4){0.f, 0.f, 0.f, 0.f};
#pragma unroll
            for (int kk = 0; kk < 4; ++kk) {
                const bf16x8 af = ld8(vsrc + kk * 32 + q * 8);
#pragma unroll
                for (int dt = 0; dt < 4; ++dt) { const bf16x8 bf = *(const LAS bf16x8*)(ks + (dt * 16 + l15) * 136 + kk * 32 + q * 8); acc[dt] = mfma16(af, bf, acc[dt]); }
            }
            float* dst = kv + ((size_t)((b * 4 + h) * 2 + dir) * 18 + n) * 4096;
#pragma unroll
            for (int dt = 0; dt < 4; ++dt)
#pragma unroll
                for (int jj = 0; jj < 4; ++jj) dst[(et * 16 + q * 4 + jj) * 64 + dt * 16 + l15] = acc[dt][jj];
        }
        __syncthreads();
    }
}

template <bool LOCAL>
DI void attn2_task(const bf16_t* p, const bf16_t* vtl, const bf16_t* vtc, const LAS float* rpbh  , bf16_t* y, int b, int h, int qrow0, int r, int pr, int lane) {
    constexpr int NB = LOCAL ? 12 : 4, NLB = LOCAL ? 8 : 0;
    constexpr float C1 = 0.125f * 1.44269504089f;
    const int l15 = lane & 15, q = lane >> 4, kperm = 8 * (l15 >> 2) + (l15 & 3);
    bf16x8 qf[2][2];
#pragma unroll
    for (int g = 0; g < 2; ++g) { const bf16_t* qsrc = p + (size_t)(qrow0 + g * 16 + l15) * DIN + 2048 + h * 64 + q * 8; qf[g][0] = ld8(qsrc); qf[g][1] = ld8(qsrc + 32); }
    const int rs = min(max(r - 4, 0), 24);
    unsigned inval = 0u; int boff[2];
    if (LOCAL) {
#pragma unroll
        for (int g = 0; g < 2; ++g) {
            const int qc = (2 * pr + g) * 16 + l15, qs = min(max(qc - 8, 0), 48);
            boff[g] = 63 - qc + 8 * q;
#pragma unroll
            for (int t = 0; t < 4; ++t)
#pragma unroll
                for (int jj = 0; jj < 4; ++jj) { const int kcol = (t >> 1) * 32 + 8 * q + 4 * (t & 1) + jj; if (!((kcol >= qs) && (kcol < qs + 16))) inval |= 1u << (g * 16 + t * 4 + jj); }
        }
    }
    float mrun[2] = {-3.0e38f, -3.0e38f}, sum[2] = {0.f, 0.f};
    f32x4 o[4][2];
#pragma unroll
    for (int et = 0; et < 4; ++et) { o[et][0] = (f32x4){0.f, 0.f, 0.f, 0.f}; o[et][1] = o[et][0]; }
    const bf16_t* kbase = p + 2304 + h * 64 + q * 8;
    bf16x8 kc[4][2], kn[4][2];
#define A2_LOADK(dst, blk_) do { const int kr0_ = (LOCAL && (blk_) < NLB) ? b * 2048 + (rs + (blk_)) * 64 : TL + b * 256 + ((blk_) - NLB) * 64; \
        _Pragma("unroll") for (int t = 0; t < 4; ++t) { const bf16_t* ks_ = kbase + (size_t)(kr0_ + (t >> 1) * 32 + kperm + 4 * (t & 1)) * DIN; dst[t][0] = ld8(ks_); dst[t][1] = ld8(ks_ + 32); } } while (0)
    A2_LOADK(kc, 0);
#pragma unroll
    for (int t = 0; t < 4; ++t) { kn[t][0] = kc[t][0]; kn[t][1] = kc[t][1]; }
#pragma unroll 1
    for (int blk = 0; blk < NB; ++blk) {
        const bool loc = LOCAL && blk < NLB;
        bf16x8 vf[2][4];
        {
            const bf16_t* vb = loc ? vtl + ((size_t)(b * 4 + h) * 64 + l15) * 2048 + (rs + blk) * 64 + q * 8 : vtc + ((size_t)(b * 4 + h) * 64 + l15) * 256 + (blk - NLB) * 64 + q * 8;
            const int vld = loc ? 2048 : 256;
#pragma unroll
            for (int hb = 0; hb < 2; ++hb)
#pragma unroll
                for (int et = 0; et < 4; ++et) vf[hb][et] = ld8(vb + (size_t)(et * 16) * vld + hb * 32);
        }
        if (blk + 1 < NB) A2_LOADK(kn, blk + 1);
        const LAS float* brow = rpbh + (rs + blk - r + 7) * 128;
#pragma unroll
        for (int g = 0; g < 2; ++g) {
            bool use[2]; use[0] = !loc || (g != pr) || (pr == 0); use[1] = !loc || (g != pr) || (pr == 1);
            f32x4 s[4];
            float mx = -3.0e38f;
#pragma unroll
            for (int t = 0; t < 4; ++t) {
                if (use[t >> 1]) {
                    f32x4 acc = {0.f, 0.f, 0.f, 0.f}; acc = mfma16(kc[t][0], qf[g][0], acc); acc = mfma16(kc[t][1], qf[g][1], acc);
                    if (loc) {
#pragma unroll
                        for (int jj = 0; jj < 4; ++jj) {
                            const float bias = brow[boff[g] + (t >> 1) * 32 + 4 * (t & 1) + jj];
                            const int im = __builtin_amdgcn_sbfe(inval, g * 16 + t * 4 + jj, 1);
                            acc[jj] = (acc[jj] * C1 + bias) + __int_as_float(im & (int)0xF149F2CA);
                        }
                    } else { acc = acc * C1; }
                    s[t] = acc;
                    mx = fmaxf(mx, fmaxf(fmaxf(acc[0], acc[1]), fmaxf(acc[2], acc[3])));
                } else s[t] = (f32x4){0.f, 0.f, 0.f, 0.f};
            }
            mx = fmaxf(mx, __shfl_xor(mx, 16)); mx = fmaxf(mx, __shfl_xor(mx, 32));
            const float mnew = fmaxf(mrun[g], mx), resc = __builtin_amdgcn_exp2f(mrun[g] - mnew);
            mrun[g] = mnew;
#pragma unroll
            for (int et = 0; et < 4; ++et) o[et][g] = o[et][g] * resc;
            float ps = 0.f;
#pragma unroll
            for (int t = 0; t < 4; ++t) if (use[t >> 1]) {
#pragma unroll
                for (int jj = 0; jj < 4; ++jj) { const float e = __builtin_amdgcn_exp2f(s[t][jj] - mnew); s[t][jj] = e; ps += e; }
            }
            ps += __shfl_xor(ps, 16); ps += __shfl_xor(ps, 32);
            sum[g] = sum[g] * resc + ps;
#pragma unroll
            for (int hb = 0; hb < 2; ++hb) if (use[hb]) {
                u32x4 pw; pw.x = pk2(s[2 * hb][0], s[2 * hb][1]); pw.y = pk2(s[2 * hb][2], s[2 * hb][3]); pw.z = pk2(s[2 * hb + 1][0], s[2 * hb + 1][1]); pw.w = pk2(s[2 * hb + 1][2], s[2 * hb + 1][3]);
                const bf16x8 pf = u4_as_bf8(pw);
#pragma unroll
                for (int et = 0; et < 4; ++et) o[et][g] = mfma16(vf[hb][et], pf, o[et][g]);
            }
        }
#pragma unroll
        for (int t = 0; t < 4; ++t) { kc[t][0] = kn[t][0]; kc[t][1] = kn[t][1]; }
    }
#undef A2_LOADK
#pragma unroll
    for (int g = 0; g < 2; ++g) {
        const float inv = 1.0f / sum[g];
        bf16_t* dst = y + (size_t)(qrow0 + g * 16 + l15) * DM + 768 + h * 64 + q * 4;
#pragma unroll
        for (int et = 0; et < 4; ++et) { u32x2 w; w.x = pk2(o[et][g][0] * inv, o[et][g][1] * inv); w.y = pk2(o[et][g][2] * inv, o[et][g][3] * inv); *(u32x2*)(dst + et * 16) = w; }
    }
}

DI int ret_fexp(int n, int m) { if (n < 16) { if (m < n) return n - 1 - m; if (m == 16) return n + 1; if (m == 17) return n; return -1; } if (n == 17 && m == 16) return 0; return -1; }
DI int ret_bexp(int n, int m) { if (n < 16) { if (m > n && m < 16) return m - n - 1; if (m == 16) return 15 - n; if (m == 17) return 16 - n; return -1; } if (n == 16 && m == 17) return 0; return -1; }

DI void retout_item(const bf16_t* p, const bf16_t* vtl, const bf16_t* vtc, const float* rope, const float* decay, const float* kv, bf16_t* y, LAS unsigned char* L, int b, int h, int n, const int tidx) {
    const int tid = tidx, lane = tid & 63, wave = tid >> 6, l15 = lane & 15, q = lane >> 4;
    LAS bf16_t* Qs = (LAS bf16_t*)L;
    LAS bf16_t* Ks = Qs + 128 * 72;
    LAS bf16_t* Sf = Ks + 128 * 72;
    LAS bf16_t* Sb = Sf + 64 * 72;
    const bool lat = n < 16;
    const int row0 = lat ? b * 2048 + n * 128 : TL + b * 256 + (n - 16) * 128;
    const float lgf = -__expf(decay[h]), lgb = -__expf(decay[4 + h]);
    {
        const int idx = tid * 8, e = idx >> 6, d0 = idx & 63;
        f32x4 f0 = {0.f, 0.f, 0.f, 0.f}, f1 = f0, b0 = f0, b1 = f0;
        const float* kvf = kv + ((size_t)((b * 4 + h) * 2 + 0) * 18) * 4096 + idx;
        const float* kvb = kv + ((size_t)((b * 4 + h) * 2 + 1) * 18) * 4096 + idx;
        const float gf = __expf(lgf * 128.0f), gb = __expf(lgb * 128.0f);
        if (lat) {
            float w = 1.0f;
#pragma unroll 4
            for (int m = n - 1; m >= 0; --m) { f0 += w * *(const f32x4*)(kvf + (size_t)m * 4096); f1 += w * *(const f32x4*)(kvf + (size_t)m * 4096 + 4); w *= gf; }
            f0 += w * (gf * *(const f32x4*)(kvf + (size_t)16 * 4096) + *(const f32x4*)(kvf + (size_t)17 * 4096));
            f1 += w * (gf * *(const f32x4*)(kvf + (size_t)16 * 4096 + 4) + *(const f32x4*)(kvf + (size_t)17 * 4096 + 4));
            w = 1.0f;
#pragma unroll 4
            for (int m = n + 1; m < 16; ++m) { b0 += w * *(const f32x4*)(kvb + (size_t)m * 4096); b1 += w * *(const f32x4*)(kvb + (size_t)m * 4096 + 4); w *= gb; }
            b0 += w * (*(const f32x4*)(kvb + (size_t)16 * 4096) + gb * *(const f32x4*)(kvb + (size_t)17 * 4096));
            b1 += w * (*(const f32x4*)(kvb + (size_t)16 * 4096 + 4) + gb * *(const f32x4*)(kvb + (size_t)17 * 4096 + 4));
        } else if (n == 16) { b0 = *(const f32x4*)(kvb + (size_t)17 * 4096); b1 = *(const f32x4*)(kvb + (size_t)17 * 4096 + 4); }
        else { f0 = *(const f32x4*)(kvf + (size_t)16 * 4096); f1 = *(const f32x4*)(kvf + (size_t)16 * 4096 + 4); }
        u32x4 w; w.x = pk2(f0[0], f0[1]); w.y = pk2(f0[2], f0[3]); w.z = pk2(f1[0], f1[1]); w.w = pk2(f1[2], f1[3]);
        *(LAS u32x4*)(Sf + e * 72 + d0) = w;
        w.x = pk2(b0[0], b0[1]); w.y = pk2(b0[2], b0[3]); w.z = pk2(b1[0], b1[1]); w.w = pk2(b1[2], b1[3]);
        *(LAS u32x4*)(Sb + e * 72 + d0) = w;
    }
    {
        const int j = tid >> 2, seg = tid & 3; float v[16];
        load_rope16(p + (size_t)(row0 + j) * DIN + 768 + h * 64, seg, lat, rope, rope + 2048 * 32, n * 128 + j, v);
        u32x4 w; w.x = pk2(v[0], v[1]); w.y = pk2(v[2], v[3]); w.z = pk2(v[4], v[5]); w.w = pk2(v[6], v[7]);
        *(LAS u32x4*)(Qs + j * 72 + seg * 16) = w;
        w.x = pk2(v[8], v[9]); w.y = pk2(v[10], v[11]); w.z = pk2(v[12], v[13]); w.w = pk2(v[14], v[15]);
        *(LAS u32x4*)(Qs + j * 72 + seg * 16 + 8) = w;
        load_rope16(p + (size_t)(row0 + j) * DIN + 1024 + h * 64, seg, lat, rope, rope + 2048 * 32, n * 128 + j, v);
        w.x = pk2(v[0] * 0.125f, v[1] * 0.125f); w.y = pk2(v[2] * 0.125f, v[3] * 0.125f); w.z = pk2(v[4] * 0.125f, v[5] * 0.125f); w.w = pk2(v[6] * 0.125f, v[7] * 0.125f);
        *(LAS u32x4*)(Ks + j * 72 + seg * 16) = w;
        w.x = pk2(v[8] * 0.125f, v[9] * 0.125f); w.y = pk2(v[10] * 0.125f, v[11] * 0.125f); w.z = pk2(v[12] * 0.125f, v[13] * 0.125f); w.w = pk2(v[14] * 0.125f, v[15] * 0.125f);
        *(LAS u32x4*)(Ks + j * 72 + seg * 16 + 8) = w;
    }
    __syncthreads();
    {
        const int il = wave * 16 + l15;
        const bf16x8 qf0 = *(const LAS bf16x8*)(Qs + il * 72 + q * 8), qf1 = *(const LAS bf16x8*)(Qs + il * 72 + 32 + q * 8);
        f32x4 o[4];
#pragma unroll
        for (int et = 0; et < 4; ++et) o[et] = (f32x4){0.f, 0.f, 0.f, 0.f};
        const bf16_t* vbase = lat ? vtl + ((size_t)(b * 4 + h) * 64 + l15) * 2048 + n * 128 : vtc + ((size_t)(b * 4 + h) * 64 + l15) * 256 + (n - 16) * 128;
        const int vld = lat ? 2048 : 256;
#pragma unroll
        for (int u = 0; u < 4; ++u) {
            f32x4 st[2];
#pragma unroll
            for (int x = 0; x < 2; ++x) {
                const int jr = u * 32 + 8 * (l15 >> 2) + 4 * x + (l15 & 3);
                const bf16x8 k0 = *(const LAS bf16x8*)(Ks + jr * 72 + q * 8), k1 = *(const LAS bf16x8*)(Ks + jr * 72 + 32 + q * 8);
                f32x4 acc = {0.f, 0.f, 0.f, 0.f};
                acc = mfma16(k0, qf0, acc); acc = mfma16(k1, qf1, acc);
#pragma unroll
                for (int jj = 0; jj < 4; ++jj) { const int j = u * 32 + 8 * q + 4 * x + jj; const int dd = il - j;
                    const float dm = dd > 0 ? __expf(lgf * (float)dd) : (dd < 0 ? __expf(lgb * (float)(-dd)) : 2.0f); acc[jj] *= dm; }
                st[x] = acc;
            }
            u32x4 pw; pw.x = pk2(st[0][0], st[0][1]); pw.y = pk2(st[0][2], st[0][3]); pw.z = pk2(st[1][0], st[1][1]); pw.w = pk2(st[1][2], st[1][3]);
            const bf16x8 pf = u4_as_bf8(pw);
#pragma unroll
            for (int et = 0; et < 4; ++et) { const bf16x8 vf = ld8(vbase + (size_t)(et * 16) * vld + u * 32 + q * 8); o[et] = mfma16(vf, pf, o[et]); }
        }
        const float rf = __expf(lgf * (float)(il + 1)), rb = __expf(lgb * (float)(128 - il));
#pragma unroll
        for (int et = 0; et < 4; ++et) {
            f32x4 af = {0.f, 0.f, 0.f, 0.f}, ab = af;
            af = mfma16(*(const LAS bf16x8*)(Sf + (et * 16 + l15) * 72 + q * 8), qf0, af); af = mfma16(*(const LAS bf16x8*)(Sf + (et * 16 + l15) * 72 + 32 + q * 8), qf1, af);
            ab = mfma16(*(const LAS bf16x8*)(Sb + (et * 16 + l15) * 72 + q * 8), qf0, ab); ab = mfma16(*(const LAS bf16x8*)(Sb + (et * 16 + l15) * 72 + 32 + q * 8), qf1, ab);
            o[et] = o[et] + rf * af + rb * ab;
        }
        float sm = 0.f;
#pragma unroll
        for (int et = 0; et < 4; ++et) sm += (o[et][0] + o[et][1]) + (o[et][2] + o[et][3]);
        sm += __shfl_xor(sm, 16); sm += __shfl_xor(sm, 32);
        const float mu = sm * (1.0f / 64.0f); float vs = 0.f;
#pragma unroll
        for (int et = 0; et < 4; ++et) { o[et] = o[et] - mu; vs += (o[et][0] * o[et][0] + o[et][1] * o[et][1]) + (o[et][2] * o[et][2] + o[et][3] * o[et][3]); }
        vs += __shfl_xor(vs, 16); vs += __shfl_xor(vs, 32);
        const float rstd = rsqrtf(vs * (1.0f / 64.0f) + EPSV);
        const bf16_t* gsrc = p + (size_t)(row0 + il) * DIN + 1536 + h * 64 + q * 4;
        bf16_t* dst = y + (size_t)(row0 + il) * DM + 256 + h * 64 + q * 4;
#pragma unroll
        for (int et = 0; et < 4; ++et) { const u32x2 gw = *(const u32x2*)(gsrc + et * 16);
            u32x2 w; w.x = pk2(silu_f(bflo(gw.x)) * o[et][0] * rstd, silu_f(bfhi(gw.x)) * o[et][1] * rstd); w.y = pk2(silu_f(bflo(gw.y)) * o[et][2] * rstd, silu_f(bfhi(gw.y)) * o[et][3] * rstd);
            *(u32x2*)(dst + et * 16) = w; }
    }
}

DI void ffn_fixup_phase(const float* uB, const float* cw, bf16_t* G, int nblk, const int tidx) {
    const int gt = blockIdx.x * NTHREADS + tidx, ngt = gridDim.x * NTHREADS;
    for (int idx = gt; idx < nblk * 2 * (DFF / 4); idx += ngt) {
        const int c4 = (idx % (DFF / 4)) * 4, rb = idx / (DFF / 4), blk = rb >> 1, last = rb & 1;
        bool sstart, send;
        if (blk < 256) { sstart = (blk & 31) == 0; send = (blk & 31) == 31; } else { sstart = ((blk - 256) & 3) == 0; send = ((blk - 256) & 3) == 3; }
        const float* prev; const float* cur; const float* next; bool hp = true, hn = true;
        if (!last) { cur = uB + ((size_t)blk * 4 + 0) * NUP; next = uB + ((size_t)blk * 4 + 1) * NUP; prev = uB + ((size_t)(blk - 1) * 4 + 3) * NUP; hp = !sstart; if (sstart) prev = cur; }
        else { cur = uB + ((size_t)blk * 4 + 3) * NUP; prev = uB + ((size_t)blk * 4 + 2) * NUP; next = uB + ((size_t)(blk + 1) * 4 + 0) * NUP; hn = !send; if (send) next = cur; }
        f32x4 ca = *(const f32x4*)(cw + NUP + c4) * *(const f32x4*)(cur + c4), cb = *(const f32x4*)(cw + NUP + DFF + c4) * *(const f32x4*)(cur + DFF + c4);
        if (hp) { ca += *(const f32x4*)(cw + c4) * *(const f32x4*)(prev + c4); cb += *(const f32x4*)(cw + DFF + c4) * *(const f32x4*)(prev + DFF + c4); }
        if (hn) { ca += *(const f32x4*)(cw + 2 * NUP + c4) * *(const f32x4*)(next + c4); cb += *(const f32x4*)(cw + 2 * NUP + DFF + c4) * *(const f32x4*)(next + DFF + c4); }
        u32x2 w; w.x = pk2(silu_f(ca[0]) * cb[0], silu_f(ca[1]) * cb[1]); w.y = pk2(silu_f(ca[2]) * cb[2], silu_f(ca[3]) * cb[3]);
        *(u32x2*)(G + (size_t)(blk * 64 + (last ? 63 : 0)) * DFF + c4) = w;
    }
}

#define GSYNC() do { XcdBarrier xb_; xb_.bar = (unsigned*)(((const __attribute__((address_space(4))) Args*)__builtin_amdgcn_kernarg_segment_ptr())->ws + WS_BAR); xb_.x = xb_xcc_id(); xb_.st = (volatile LAS unsigned*)(L + 140032); xcd_barrier(xb_); } while (0)
#define FRESH() int tid = threadIdx.x; asm volatile("" : "+v"(tid)); const __attribute__((address_space(4))) Args* ap_ = (const __attribute__((address_space(4))) Args*)__builtin_amdgcn_kernarg_segment_ptr(); asm volatile("" : "+s"(ap_)); const __attribute__((address_space(4))) Args& a = *ap_; unsigned char* ws = a.ws; asm volatile("" : "+s"(ws)); const int lane = tid & 63, wave = __builtin_amdgcn_readfirstlane(tid >> 6), gw = bx * 8 + wave; (void)lane; (void)wave; (void)gw; (void)ws
__global__ void __launch_bounds__(NTHREADS) mk_fwd(Args a_k) {
    extern __shared__ __attribute__((aligned(16))) unsigned char lds_raw[];
    LAS unsigned char* L = (LAS unsigned char*)lds_raw;
    cg::grid_group grid = cg::this_grid();
    const int G = gridDim.x, bx = blockIdx.x, ngw = G * 8;
    volatile LAS unsigned* xst = (volatile LAS unsigned*)(L + 140032);
    if (threadIdx.x < 2) xst[threadIdx.x] = 0u;
    __syncthreads();
    (void)xcd_barrier_post((unsigned*)(a_k.ws + WS_BAR), xst);
    grid.sync();

    {
        FRESH();
        if (PHON(0)) { mods_phase(a, L, (float*)(ws + WS_MOD), tid); tables_phase(ws, tid); }
        if (PHON(1)) {
            convert_weight(a.in[I_WIN], DM, DIN, (bf16_t*)(ws + WS_WIN), L, gw, ngw, lane, wave);
        }
    }
    GSYNC();
    {
        FRESH();
        const float* mods = (const float*)(ws + WS_MOD);
        if (PHON(2)) rowwise_phase<false, false>(a.in[I_X], a.in[I_CTX], nullptr, nullptr, nullptr, nullptr, nullptr, a.in[I_GPREMIX], mods + 1 * 1024, mods + 0 * 1024, (bf16_t*)(ws + WS_H), TT, tid);
    }
    GSYNC();

#pragma unroll 1
    for (int l = 0; l < DEPTH; ++l) {
        const bool with_ctx = l < DEPTH - 1;
        const int Mrows = with_ctx ? TT : TL;
        if (PHON(3)) {
            FRESH();
            pg8::Gemm g{(const bf16_t*)(ws + WS_H), WSET(l) + WOFF_IN, DM, (size_t)128 * DM * 2, (size_t)128 * DM * 2, (size_t)256 * DM * 2, (size_t)256 * DM * 2};
            pg8::StaticOrder S; if (with_ctx) S.init(TT, DIN, G, bx, 16, 0, 1); else S.init(TL, DIN, G, bx, 16, 32, 1);
            pg8::EpiP E{(bf16_t*)(ws + WS_A + A_P), (bf16_t*)(ws + WS_A + A_VTRL), (bf16_t*)(ws + WS_A + A_VTRC), (bf16_t*)(ws + WS_A + A_VTNL), (bf16_t*)(ws + WS_A + A_VTNC)};
            pg8::gemm_phase<pg8::EpiP, pg8::StaticOrder, true, true>(L, g, S, E, tid);
        }
        if (PHON(1)) {
            FRESH();
            const bool nx = l + 1 < DEPTH; bf16_t* w0 = WSET(0); bf16_t* w1 = WSET(l + 1);
            const ConvJob jobs[5] = { {l == 0 ? a.in[I_WOUT] : nullptr, w0 + WOFF_OUT, DM, DM}, {l == 0 ? a.in[I_WUP] : nullptr, w0 + WOFF_UP, DM, NUP}, {l == 0 ? a.in[I_WDOWN] : nullptr, w0 + WOFF_DN, DFF, DM},
                {nx ? a.in[I_WIN] + (size_t)(l + 1) * DM * DIN : nullptr, w1 + WOFF_IN, DM, DIN}, {nx ? a.in[I_WOUT] + (size_t)(l + 1) * DM * DM : nullptr, w1 + WOFF_OUT, DM, DM} };
            filler_convert<5>(jobs, (unsigned*)(ws + WS_CTL) + 32 + l, L, tid, lane, wave);
        }
        GSYNC();
        {
            FRESH();
            const bf16_t* pbuf = (const bf16_t*)(ws + WS_A + A_P);
            if (PHON(4)) chdft_phase(pbuf, (const bf16_t*)(ws + WS_CMAT), (bf16_t*)(ws + WS_B + B_ZT), (bf16_t*)(ws + WS_B + B_ZCT), with_ctx, gw, ngw, lane);
            if (PHON(6)) retkv_phase(pbuf, (const bf16_t*)(ws + WS_A + A_VTRL), (const bf16_t*)(ws + WS_A + A_VTRC), (const float*)(ws + WS_ROPE), a.in[I_RETDECAY] + l * 8, (float*)(ws + WS_B + B_KV), L, tid, (unsigned*)(ws + WS_CTL) + 56 + l);
        }
        GSYNC();
        {
            if (PHON(7) && PHON(18)) {
                FRESH();
                pg8::Gemm g{(const bf16_t*)(ws + WS_DFT), (const bf16_t*)(ws + WS_B + B_ZT), 2048, (size_t)128 * 2048 * 2, (size_t)128 * 2048 * 2, (size_t)256 * 2048 * 2, (size_t)256 * 2048 * 2};
                pg8::FourierOrder S{bx, 1};
                pg8::EpiBf16S E{(bf16_t*)(ws + WS_A + A_Y) + 512, DM, 0.00276213586f  };
                pg8::gemm_phase<pg8::EpiBf16S, pg8::FourierOrder, false, true>(L, g, S, E, tid);
            }
            if (PHON(7) && PHON(17) && with_ctx) {
                FRESH();
                pg8::Gemm g{(const bf16_t*)(ws + WS_DFTC), (const bf16_t*)(ws + WS_B + B_ZCT), 512, (size_t)128 * 512 * 2, (size_t)128 * 512 * 2, (size_t)256 * 512 * 2, (size_t)256 * 512 * 2};
                pg8::FourierOrder S{bx, 0};
                pg8::EpiBf16S E{(bf16_t*)(ws + WS_A + A_Y) + 512, DM, 0.0078125f  };
                pg8::gemm_phase<pg8::EpiBf16S, pg8::FourierOrder, false, true>(L, g, S, E, tid);
            }
            const int n_nat = 256, n_ret = with_ctx ? 576 : 512, n_cc = with_ctx ? 32 : 0, n_sc = Mrows / 64, n_items = n_nat + n_ret + n_cc + n_sc;
            for (;;) {
                FRESH();
                LAS int* bw = (LAS int*)(L + 140000);
                __syncthreads();
                if (tid == 0) *bw = (int)atomicAdd((unsigned*)(ws + WS_CTL) + 16 + l, 1u);
                __syncthreads();
                const int it = __builtin_amdgcn_readfirstlane(*bw);
                if (it >= n_items) break;
                const bf16_t* pbuf = (const bf16_t*)(ws + WS_A + A_P); bf16_t* ybuf = (bf16_t*)(ws + WS_A + A_Y);
                const float* rpb = a.in[I_RPB] + (size_t)l * 4 * 15 * 31;
                if (PHON(8) && it < n_nat) {
                    const int b = it >> 5, r = it & 31;
                    LAS float* rl = (LAS float*)L;
                    for (int i = tid; i < 4 * 15 * 128; i += NTHREADS) { const int d = (i & 127) - 63, hr = i >> 7; rl[i] = (d >= -15 && d <= 15) ? rpb[hr * 31 + d + 15] * 1.44269504089f : 0.f; }
                    __syncthreads();
                    { const int h = wave >> 1, pr = wave & 1;
                      attn2_task<true>(pbuf, (const bf16_t*)(ws + WS_A + A_VTNL), (const bf16_t*)(ws + WS_A + A_VTNC), rl + h * 1920, ybuf, b, h, b * 2048 + r * 64 + pr * 32, r, pr, lane); }
                } else if (PHON(9) && it >= n_nat && it < n_nat + n_ret) {
                    const int k = it - n_nat; int b, h, n;
                    if (with_ctx) { b = k / 72; h = (k / 18) & 3; n = k % 18; } else { b = k >> 6; h = (k >> 4) & 3; n = k & 15; }
                    retout_item(pbuf, (const bf16_t*)(ws + WS_A + A_VTRL), (const bf16_t*)(ws + WS_A + A_VTRC), (const float*)(ws + WS_ROPE), a.in[I_RETDECAY] + l * 8, (const float*)(ws + WS_B + B_KV), ybuf, L, b, h, n, tid);
                } else if (PHON(10) && it >= n_nat + n_ret && it < n_nat + n_ret + n_cc) {
                    const int k = it - n_nat - n_ret, b = k >> 2, h = k & 3;
                    attn2_task<false>(pbuf, (const bf16_t*)(ws + WS_A + A_VTNL), (const bf16_t*)(ws + WS_A + A_VTNC), (const LAS float*)L, ybuf, b, h, TL + b * 256 + wave * 32, 0, 0, lane);
                } else if (PHON(5) && it >= n_nat + n_ret + n_cc) {
                    sconv_item(pbuf, a.in[I_CONVW] + l * 768, ybuf, (it - n_nat - n_ret - n_cc) * 64, tid);
                }
            }
        }
        GSYNC();
        if (PHON(11)) {
            FRESH();
            pg8::Gemm g{(const bf16_t*)(ws + WS_A + A_Y), WSET(l) + WOFF_OUT, DM, (size_t)128 * DM * 2, (size_t)128 * DM * 2, (size_t)256 * DM * 2, (size_t)256 * DM * 2};
            pg8::SplitOrder S; S.init(G, bx, with_ctx ? 1 : 0, 16);
            pg8::EpiF32 E{(bf16_t*)(ws + WS_B + B_O1), DM, 16};
            pg8::gemm_phase<pg8::EpiF32, pg8::SplitOrder, true, true>(L, g, S, E, tid);
        }
        GSYNC();
        {
            FRESH();
            const float* modl = (const float*)(ws + WS_MOD) + (size_t)l * 9 * 6144;
            if (PHON(12) && l == 0) rowwise_phase<false, true>(a.in[I_X], a.in[I_CTX], nullptr, (bf16_t*)(ws + WS_XB), (const bf16_t*)(ws + WS_B + B_O1), a.in[I_GPOSTMIX] + l * DM, modl + 2 * 1024, a.in[I_GPREFFN] + l * DM, modl + 4 * 1024, modl + 3 * 1024, (bf16_t*)(ws + WS_H), Mrows, tid);
            if (PHON(12) && l != 0) rowwise_phase<true, true>(nullptr, nullptr, nullptr, (bf16_t*)(ws + WS_XB), (const bf16_t*)(ws + WS_B + B_O1), a.in[I_GPOSTMIX] + l * DM, modl + 2 * 1024, a.in[I_GPREFFN] + l * DM, modl + 4 * 1024, modl + 3 * 1024, (bf16_t*)(ws + WS_H), Mrows, tid);
        }
        GSYNC();
        if (PHON(13)) {
            FRESH();
            pg8::Gemm g{(const bf16_t*)(ws + WS_H), WSET(l) + WOFF_UP, DM, (size_t)128 * DM * 2, (size_t)DFF * DM * 2, (size_t)256 * DM * 2, (size_t)128 * DM * 2};
            pg8::StaticOrder S; S.init(Mrows, NUP, G, bx, 16);
            pg8::EpiUp E{(bf16_t*)(ws + WS_B + B_G), (float*)(ws + WS_A + A_UB), a.in[I_FFNCONVW] + (size_t)l * 3 * NUP};
            pg8::gemm_phase<pg8::EpiUp, pg8::StaticOrder, true, true>(L, g, S, E, tid);
        }
        if (PHON(1) && l + 1 < DEPTH) {
            FRESH();
            bf16_t* w1 = WSET(l + 1);
            const ConvJob jobs[2] = { {a.in[I_WUP] + (size_t)(l + 1) * DM * NUP, w1 + WOFF_UP, DM, NUP}, {a.in[I_WDOWN] + (size_t)(l + 1) * DFF * DM, w1 + WOFF_DN, DFF, DM} };
            filler_convert<2>(jobs, (unsigned*)(ws + WS_CTL) + 40 + l, L, tid, lane, wave);
        }
        GSYNC();
        {
            FRESH();
            if (PHON(14)) ffn_fixup_phase((const float*)(ws + WS_A + A_UB), a.in[I_FFNCONVW] + (size_t)l * 3 * NUP, (bf16_t*)(ws + WS_B + B_G), Mrows / 64, tid);
        }
        GSYNC();
        if (PHON(15)) {
            FRESH();
            pg8::Gemm g{(const bf16_t*)(ws + WS_B + B_G), WSET(l) + WOFF_DN, DFF, (size_t)128 * DFF * 2, (size_t)128 * DFF * 2, (size_t)256 * DFF * 2, (size_t)256 * DFF * 2};
            pg8::SplitOrder S; S.init(G, bx, with_ctx ? 1 : 0, 44);
            pg8::EpiF32 E{(bf16_t*)(ws + WS_A + A_O2), DM, 44};
            pg8::gemm_phase<pg8::EpiF32, pg8::SplitOrder, true, true>(L, g, S, E, tid);
        }
        GSYNC();
        {
            FRESH();
            const float* modl = (const float*)(ws + WS_MOD) + (size_t)l * 9 * 6144;
            if (!PHON(16)) {} else if (l + 1 < DEPTH) {
                const float* modn = modl + 9 * 6144;
                rowwise_phase<true, true>(nullptr, nullptr, nullptr, (bf16_t*)(ws + WS_XB), (const bf16_t*)(ws + WS_A + A_O2), a.in[I_GPOSTFFN] + l * DM, modl + 5 * 1024, a.in[I_GPREMIX] + (l + 1) * DM, modn + 1 * 1024, modn + 0 * 1024, (bf16_t*)(ws + WS_H), Mrows, tid);
            } else {
                rowwise_phase<true, false>(nullptr, nullptr, a.out, (bf16_t*)(ws + WS_XB), (const bf16_t*)(ws + WS_A + A_O2), a.in[I_GPOSTFFN] + l * DM, modl + 5 * 1024, nullptr, nullptr, nullptr, nullptr, Mrows, tid);
            }
        }
        if (l + 1 < DEPTH) GSYNC();
    }
}

extern "C" void kernel_launch(void* const* d_in, const int* in_sizes, int n_in, void* d_out, int out_size, void* d_ws, size_t ws_size, hipStream_t stream) {
    static int grid_blocks = 0;
    if (grid_blocks == 0) {
        if (n_in != 18 || ws_size < WS_END) { fprintf(stderr, "kernel_launch: bad sizes n_in %d ws %zu need %zu\n", n_in, ws_size, (size_t)WS_END); grid_blocks = -1; return; }
        int dev = 0, cus = 0, per_cu = 0;
        hipGetDevice(&dev);
        hipDeviceGetAttribute(&cus, hipDeviceAttributeMultiprocessorCount, dev);
        if (hipFuncSetAttribute((const void*)mk_fwd, hipFuncAttributeMaxDynamicSharedMemorySize, LDS_BYTES) != hipSuccess) { fprintf(stderr, "kernel_launch: hipFuncSetAttribute failed\n"); grid_blocks = -1; return; }
        if (hipOccupancyMaxActiveBlocksPerMultiprocessor(&per_cu, (const void*)mk_fwd, NTHREADS, LDS_BYTES) != hipSuccess || per_cu < 1) { fprintf(stderr, "kernel_launch: occupancy query failed (%d)\n", per_cu); (void)hipGetLastError(); per_cu = 1; }
        grid_blocks = cus * 1;
        fprintf(stderr, "kernel_launch: cus %d per_cu %d grid %d ws %zu need %zu\n", cus, per_cu, grid_blocks, ws_size, (size_t)WS_END);
    }
    if (grid_blocks < 0) return;
    (void)hipMemsetAsync((char*)d_ws + WS_CTL, 0, 32768, stream);
    Args a{};
    for (int i = 0; i < 18; ++i) a.in[i] = (const float*)d_in[i];
    a.out = (float*)d_out; a.ws = (unsigned char*)d_ws;
    void* args[] = {&a};
    hipError_t e = hipLaunchCooperativeKernel((const void*)mk_fwd, dim3(grid_blocks), dim3(NTHREADS), args, LDS_BYTES, stream);
    if (e != hipSuccess) fprintf(stderr, "cooperative launch failed: %s (grid %d)\n", hipGetErrorString(e), grid_blocks);
}
```
